# Optimizing an MI355X kernel written in HIP

```python
import math
import jax, jax.numpy as jnp
from jax import lax
import numpy as np

D_MODEL = 1024
BATCH = 4
SEQ = 4096
DEPTH = 4

N_A = DEPTH // 2
N_B = DEPTH - N_A
TOK_WIDTH = 3 * D_MODEL // 4
MEM_HEADS = 4
MEM_HEAD_DIM = 64
MEM_WIDTH = MEM_HEADS * MEM_HEAD_DIM
MIX_WIDTH = TOK_WIDTH + MEM_WIDTH
N_MEM = 256
S5_GROUP = 16
S5_GROUPS = TOK_WIDTH // S5_GROUP
S5_STATE = 64
DT_MIN, DT_MAX = 1e-3, 1e-1
DIFF_HEAD_DIM = 64
DIFF_HEADS = TOK_WIDTH // (2 * DIFF_HEAD_DIM)
DIFF_V_DIM = 2 * DIFF_HEAD_DIM
QK_WIDTH = DIFF_HEADS * 2 * DIFF_HEAD_DIM
V_WIDTH = DIFF_HEADS * DIFF_V_DIM
ROT_DIM = DIFF_HEAD_DIM // 4
ROPE_THETA = 500000.0
Q_BLOCK = 128
D_FF = 2816
EPS = 1e-6

kernel_name = 'yoco_s5_diffattn_macaron_memory'


def rms_norm(x, g):
    xf = x.astype(jnp.float32)
    y = xf * lax.rsqrt(jnp.mean(xf * xf, axis=-1, keepdims=True) + EPS)
    return (y * g.astype(jnp.float32)).astype(x.dtype)


def swiglu(h, w_in, w_out):
    gu = h @ w_in
    return (jax.nn.silu(gu[..., :D_FF]) * gu[..., D_FF:]) @ w_out


def rope_tables(positions):
    inv = ROPE_THETA ** (-jnp.arange(0, ROT_DIM, 2, dtype=jnp.float32) / ROT_DIM)
    ang = positions.astype(jnp.float32)[..., None] * inv
    return jnp.cos(ang), jnp.sin(ang)


def partial_rope(t, cos, sin):
    half = ROT_DIM // 2
    c = cos[:, :, None, None, :]
    s = sin[:, :, None, None, :]
    t1 = t[..., :half].astype(jnp.float32)
    t2 = t[..., half:ROT_DIM].astype(jnp.float32)
    r = jnp.concatenate([t1 * c - t2 * s, t2 * c + t1 * s], axis=-1).astype(t.dtype)
    return jnp.concatenate([r, t[..., ROT_DIM:]], axis=-1)


def _ssm_combine(e1, e2):
    a1r, a1i, b1r, b1i = e1
    a2r, a2i, b2r, b2i = e2
    ar = a1r * a2r - a1i * a2i
    ai = a1r * a2i + a1i * a2r
    br = a2r * b1r - a2i * b1i + b2r
    bi = a2r * b1i + a2i * b1r + b2i
    return (ar, ai, br, bi)


def s5_mixer(u, a_re, a_im, log_dt, b_re, b_im, c_re, c_im, d, w_glu):
    f32 = jnp.float32
    bsz, seq, _ = u.shape
    ug = u.astype(f32).reshape(bsz, seq, S5_GROUPS, S5_GROUP)
    dt = jnp.exp(log_dt.astype(f32))[:, None]
    lr, li = a_re.astype(f32), a_im.astype(f32)
    mag = jnp.exp(lr * dt)
    abr, abi = mag * jnp.cos(li * dt), mag * jnp.sin(li * dt)
    den = lr * lr + li * li
    nr, ni = abr - 1.0, abi
    fr = (nr * lr + ni * li) / den
    fi = (ni * lr - nr * li) / den
    br, bi = b_re.astype(f32), b_im.astype(f32)
    bbr = fr[..., None] * br - fi[..., None] * bi
    bbi = fr[..., None] * bi + fi[..., None] * br
    bu_r = jnp.einsum('bsgc,gpc->bsgp', ug, bbr)
    bu_i = jnp.einsum('bsgc,gpc->bsgp', ug, bbi)
    a_r = jnp.broadcast_to(abr, (1, seq) + abr.shape)
    a_i = jnp.broadcast_to(abi, (1, seq) + abi.shape)
    _, _, hr, hi = lax.associative_scan(_ssm_combine, (a_r, a_i, bu_r, bu_i), axis=1)
    y = (jnp.einsum('bsgp,gcp->bsgc', hr, c_re.astype(f32))
         - jnp.einsum('bsgp,gcp->bsgc', hi, c_im.astype(f32))
         + d.astype(f32) * ug)
    y = jax.nn.gelu(y.reshape(bsz, seq, TOK_WIDTH))
    y = y * jax.nn.sigmoid(y @ w_glu.astype(f32))
    return y.astype(u.dtype)


def diff_attention(q, k, v, lam):
    bsz, seq = q.shape[0], q.shape[1]
    nblk = seq // Q_BLOCK
    scale = DIFF_HEAD_DIM ** -0.5
    qb = q.reshape(bsz, nblk, Q_BLOCK, DIFF_HEADS, 2, DIFF_HEAD_DIM).transpose(1, 0, 2, 3, 4, 5)
    kidx = jnp.arange(seq)

    def one_block(args):
        qblk, blk = args
        s = jnp.einsum('bqhcd,bkhcd->bhcqk', qblk, k, preferred_element_type=jnp.float32) * scale
        qidx = blk * Q_BLOCK + jnp.arange(Q_BLOCK)
        mask = kidx[None, :] <= qidx[:, None]
        s = jnp.where(mask, s, -jnp.inf)
        p = jax.nn.softmax(s, axis=-1)
        a = p[:, :, 0] - lam * p[:, :, 1]
        return jnp.einsum('bhqk,bkhe->bqhe', a.astype(v.dtype), v)

    o = lax.map(one_block, (qb, jnp.arange(nblk)))
    return o.transpose(1, 0, 2, 3, 4).reshape(bsz, seq, DIFF_HEADS, DIFF_V_DIM)


def memory_attention(q, mk, mv):
    s = jnp.einsum('bshd,bmhd->bhsm', q, mk, preferred_element_type=jnp.float32) * MEM_HEAD_DIM ** -0.5
    p = jax.nn.softmax(s, axis=-1)
    return jnp.einsum('bhsm,bmhd->bshd', p.astype(mv.dtype), mv)


def setup_inputs(seed: int = 0) -> dict:
    key = jax.random.key(seed)
    ks = iter(jax.random.split(key, 48))
    f32 = jnp.float32

    def nrm(shape, scale):
        return jax.random.normal(next(ks), shape, f32) * scale

    def gain(shape):
        return 1.0 + nrm(shape, 0.02)

    x = jax.random.normal(next(ks), (BATCH, SEQ, D_MODEL), f32)
    mem = jax.random.normal(next(ks), (BATCH, N_MEM, D_MODEL), f32)
    offset = jax.random.randint(next(ks), (BATCH, 1), 0, 1024, dtype=jnp.int32)
    positions = offset + jnp.arange(SEQ, dtype=jnp.int32)[None, :]
    n_idx = jnp.arange(S5_STATE, dtype=f32)
    return {
        'x': x,
        'mem': mem,
        'positions': positions,
        'ln_ffn1': gain((DEPTH, D_MODEL)),
        'ffn1_in': nrm((DEPTH, D_MODEL, 2 * D_FF), D_MODEL ** -0.5),
        'ffn1_out': nrm((DEPTH, D_FF, D_MODEL), D_FF ** -0.5),
        'ln_mix': gain((DEPTH, D_MODEL)),
        'w_mix_in': nrm((DEPTH, D_MODEL, MIX_WIDTH), D_MODEL ** -0.5),
        'w_mix_out': nrm((DEPTH, MIX_WIDTH, D_MODEL), MIX_WIDTH ** -0.5),
        'ln_mem': gain((D_MODEL,)),
        'w_mem_kv': nrm((DEPTH, D_MODEL, 2 * MEM_WIDTH), D_MODEL ** -0.5),
        'ln_ffn2': gain((DEPTH, D_MODEL)),
        'ffn2_in': nrm((DEPTH, D_MODEL, 2 * D_FF), D_MODEL ** -0.5),
        'ffn2_out': nrm((DEPTH, D_FF, D_MODEL), D_FF ** -0.5),
        's5_a_re': -0.5 + nrm((N_A, S5_GROUPS, S5_STATE), 0.01),
        's5_a_im': math.pi * n_idx + nrm((N_A, S5_GROUPS, S5_STATE), 0.01),
        's5_log_dt': jax.random.uniform(next(ks), (N_A, S5_GROUPS), f32, math.log(DT_MIN), math.log(DT_MAX)),
        's5_b_re': nrm((N_A, S5_GROUPS, S5_STATE, S5_GROUP), (2 * S5_GROUP) ** -0.5),
        's5_b_im': nrm((N_A, S5_GROUPS, S5_STATE, S5_GROUP), (2 * S5_GROUP) ** -0.5),
        's5_c_re': nrm((N_A, S5_GROUPS, S5_GROUP, S5_STATE), (2 * S5_STATE) ** -0.5),
        's5_c_im': nrm((N_A, S5_GROUPS, S5_GROUP, S5_STATE), (2 * S5_STATE) ** -0.5),
        's5_d': nrm((N_A, S5_GROUPS, S5_GROUP), 1.0),
        's5_w_glu': nrm((N_A, TOK_WIDTH, TOK_WIDTH), TOK_WIDTH ** -0.5),
        'ln_kv': gain((D_MODEL,)),
        'w_kv_shared': nrm((D_MODEL, QK_WIDTH + V_WIDTH), D_MODEL ** -0.5),
        'diff_lq1': nrm((N_B, DIFF_HEAD_DIM), 0.1),
        'diff_lk1': nrm((N_B, DIFF_HEAD_DIM), 0.1),
        'diff_lq2': nrm((N_B, DIFF_HEAD_DIM), 0.1),
        'diff_lk2': nrm((N_B, DIFF_HEAD_DIM), 0.1),
        'diff_subln': gain((N_B, DIFF_V_DIM)),
        'ln_final': gain((D_MODEL,)),
    }


def reference(x, mem, positions, ln_ffn1, ffn1_in, ffn1_out, ln_mix, w_mix_in, w_mix_out,
              ln_mem, w_mem_kv, ln_ffn2, ffn2_in, ffn2_out,
              s5_a_re, s5_a_im, s5_log_dt, s5_b_re, s5_b_im, s5_c_re, s5_c_im, s5_d, s5_w_glu,
              ln_kv, w_kv_shared, diff_lq1, diff_lk1, diff_lq2, diff_lk2, diff_subln, ln_final):
    bsz, seq, _ = x.shape
    n_mem = mem.shape[1]
    cos, sin = rope_tables(positions)
    mem_n = rms_norm(mem, ln_mem)
    k_sh = None
    v_sh = None
    for i in range(DEPTH):
        if i == N_A:
            hk = rms_norm(x, ln_kv)
            kv = hk @ w_kv_shared
            k_sh = partial_rope(kv[..., :QK_WIDTH].reshape(bsz, seq, DIFF_HEADS, 2, DIFF_HEAD_DIM), cos, sin)
            v_sh = kv[..., QK_WIDTH:].reshape(bsz, seq, DIFF_HEADS, DIFF_V_DIM)
        x = x + 0.5 * swiglu(rms_norm(x, ln_ffn1[i]), ffn1_in[i], ffn1_out[i])
        h = rms_norm(x, ln_mix[i])
        proj = h @ w_mix_in[i]
        tok_in = proj[..., :TOK_WIDTH]
        mq = proj[..., TOK_WIDTH:].reshape(bsz, seq, MEM_HEADS, MEM_HEAD_DIM)
        if i < N_A:
            j = i
            tok_out = s5_mixer(tok_in, s5_a_re[j], s5_a_im[j], s5_log_dt[j], s5_b_re[j], s5_b_im[j],
                               s5_c_re[j], s5_c_im[j], s5_d[j], s5_w_glu[j])
        else:
            j = i - N_A
            q = partial_rope(tok_in.reshape(bsz, seq, DIFF_HEADS, 2, DIFF_HEAD_DIM), cos, sin)
            lam_init = 0.8 - 0.6 * math.exp(-0.3 * i)
            lam = (jnp.exp(jnp.sum(diff_lq1[j].astype(jnp.float32) * diff_lk1[j].astype(jnp.float32)))
                   - jnp.exp(jnp.sum(diff_lq2[j].astype(jnp.float32) * diff_lk2[j].astype(jnp.float32)))
                   + lam_init)
            o = diff_attention(q, k_sh, v_sh, lam)
            o = rms_norm(o, diff_subln[j]) * (1.0 - lam_init)
            tok_out = o.reshape(bsz, seq, TOK_WIDTH)
        mkv = mem_n @ w_mem_kv[i]
        mk = mkv[..., :MEM_WIDTH].reshape(bsz, n_mem, MEM_HEADS, MEM_HEAD_DIM)
        mv = mkv[..., MEM_WIDTH:].reshape(bsz, n_mem, MEM_HEADS, MEM_HEAD_DIM)
        mo = memory_attention(mq, mk, mv).reshape(bsz, seq, MEM_WIDTH)
        x = x + jnp.concatenate([tok_out, mo], axis=-1) @ w_mix_out[i]
        x = x + 0.5 * swiglu(rms_norm(x, ln_ffn2[i]), ffn2_in[i], ffn2_out[i])
    return rms_norm(x, ln_final)
```

```cpp
#include <hip/hip_runtime.h>
#include <hip/hip_cooperative_groups.h>
#include <cstdio>
#include <cstdint>
namespace cg = cooperative_groups;
#ifndef MK_MULTI
#define MK_MULTI 0
#endif
#define PROBE_DUP 0
namespace pg8 {
#define PG8_LAS __attribute__((address_space(3)))
typedef unsigned short bf16_t;
typedef short bf16x8 __attribute__((ext_vector_type(8)));
typedef float f32x4 __attribute__((ext_vector_type(4)));
typedef unsigned u32x4 __attribute__((ext_vector_type(4)));
constexpr int BM = 256, BK = 64, HALF = 128, HTB = HALF * BK * 2  , STAGE_BYTES = 8 * HTB, NXCD = 8, WGM = 8;

__host__ __device__ __forceinline__ int lds_byte(int r, int c) { const int st = (r >> 4) * 2 + (c >> 5), rr = r & 15, cc = c & 31, ob = rr * 64 + cc * 2; return st * 1024 + (ob ^ (((ob >> 9) & 1) << 5)); }
__host__ __device__ __forceinline__ void stage_rc(int b, int& R, int& C) { const int st = b / 1024, sb = b % 1024, swz = sb ^ (((sb >> 9) & 1) << 5); R = (st >> 1) * 16 + swz / 64; C = (st & 1) * 32 + (swz % 64) / 2; }
__host__ __device__ __forceinline__ int perm32(int rho) { const int n = rho >> 4, i = rho & 15; return 8 * (i >> 2) + 4 * n + (i & 3); }

struct Unit { int pm, pn; };
struct Gemm { const bf16_t* A; const bf16_t* Bt; int M, N, K; };

struct StaticOrder {
    int nM, nN, nwg, G, c;
    __host__ __device__ void init(int M, int N, int G_, int c_) { nM = M / BM; nN = N / BM; nwg = nM * nN; G = G_; c = c_; }
    __host__ __device__ bool next(int i, Unit& u) const {
        const long L = (long)i * G + c; if (L >= nwg) return false;
        int wgid = (int)L; { const int q = nwg / NXCD, r = nwg % NXCD, xcd = wgid % NXCD, off = wgid / NXCD; wgid = (xcd < r ? xcd * (q + 1) : r * (q + 1) + (xcd - r) * q) + off; }
        const int nig = WGM * nN, gid = wgid / nig, fm = gid * WGM, gsz = (nM - fm) < WGM ? (nM - fm) : WGM;
        u.pm = fm + ((wgid % nig) % gsz); u.pn = (wgid % nig) / gsz; return true;
    }
    __device__ __forceinline__ void a_ready(const Unit&) const {}
    __device__ __forceinline__ void done(const Unit&) const {}
};

__device__ __forceinline__ unsigned cvt_pk_bf16(float lo, float hi) { unsigned r; asm volatile("v_cvt_pk_bf16_f32 %0, %1, %2" : "=v"(r) : "v"(lo), "v"(hi)); return r; }
template <class Epi, class Sched, bool ALIGN_EPI = false, bool SP2 = false>
__device__ __forceinline__ void gemm_phase(PG8_LAS unsigned char* lds, const Gemm g, const Sched& S, const Epi& E, const int tid_in) {
    const int tid = tid_in, wid = __builtin_amdgcn_readfirstlane(tid >> 6), lane = tid & 63, wr = wid >> 2, wc = wid & 3, fr = lane & 15, fq = lane >> 4;
    const int K = g.K, nt = K / BK;
    unsigned voffA[2], voffB[2];
#pragma unroll
    for (int i = 0; i < 2; ++i) { int R, C; stage_rc(tid * 16 + i * 8192, R, C); const int Rb = Epi::PERM ? ((R & ~31) + perm32(R & 31)) : R;
        voffA[i] = (unsigned)(R * K + C) * 2u; voffB[i] = (unsigned)(Rb * K + C) * 2u; }
    const size_t kstep = (size_t)(BK * 2);
    const size_t hstep = (size_t)HALF * K * 2;
    const size_t tstep = 2 * hstep;
    const unsigned ldsw = (unsigned)wid * 1024u;
    const int aoff = lds_byte(wr * 64 + fr, fq * 8), boff = lds_byte(wc * 32 + fr, fq * 8);
#define PG8_SA(b, h) (((b) * 2 + (h)) * HTB)
#define PG8_SB(b, h) ((4 + (b) * 2 + (h)) * HTB)
#define PG8_STAGE(bufoff, gbase, voff) do { _Pragma("unroll") for (int _i = 0; _i < 2; ++_i) \
        __builtin_amdgcn_global_load_lds((const unsigned*)((const char*)(gbase) + (voff)[_i]), (PG8_LAS unsigned*)(lds + (bufoff) + ldsw + _i * 8192), 16, 0, 0); } while (0)
#define PG8_LDA(dst, b, h) do { _Pragma("unroll") for (int m = 0; m < 4; ++m) _Pragma("unroll") for (int k = 0; k < 2; ++k) dst[m][k] = *(const PG8_LAS bf16x8*)(lds + PG8_SA(b, h) + aoff + m * 2048 + k * 1024); } while (0)
#define PG8_LDB(dst, b, h) do { _Pragma("unroll") for (int n = 0; n < 2; ++n) _Pragma("unroll") for (int k = 0; k < 2; ++k) dst[n][k] = *(const PG8_LAS bf16x8*)(lds + PG8_SB(b, h) + boff + n * 2048 + k * 1024); } while (0)
#define PG8_MMA(ai, bj, At, Bt) do { __builtin_amdgcn_s_setprio(1); _Pragma("unroll") for (int m = 0; m < 4; ++m) _Pragma("unroll") for (int n = 0; n < 2; ++n) _Pragma("unroll") for (int k = 0; k < 2; ++k) \
        acc[ai][bj][m][n] = __builtin_amdgcn_mfma_f32_16x16x32_bf16(Bt[n][k], At[m][k], acc[ai][bj][m][n], 0, 0, 0); __builtin_amdgcn_s_setprio(0); } while (0)
#define PG8_WAIT_V(n) asm volatile("s_waitcnt vmcnt(" #n ")" ::: "memory")
#define PG8_WAIT_L(n) asm volatile("s_waitcnt lgkmcnt(" #n ")" ::: "memory")
#define PG8_BAR __builtin_amdgcn_s_barrier()
#define PG8_SCHED __builtin_amdgcn_sched_barrier(0)
    Unit cur, nxt; int ui = 0;
    if (!S.next(0, cur)) return;
    f32x4 acc[2][2][4][2];
#pragma unroll
    for (int a = 0; a < 2; ++a)
#pragma unroll
        for (int b = 0; b < 2; ++b)
#pragma unroll
            for (int m = 0; m < 4; ++m)
#pragma unroll
                for (int n = 0; n < 2; ++n) acc[a][b][m][n] = (f32x4){0.f, 0.f, 0.f, 0.f};
    bf16x8 At[4][2], B0[2][2], B1[2][2];
    const char* cA = (const char*)g.A + (size_t)cur.pm * tstep; const char* cB = (const char*)g.Bt + (size_t)cur.pn * tstep;
    S.a_ready(cur);
    if constexpr (SP2) {
        PG8_STAGE(PG8_SB(0, 0), cB, voffB); PG8_STAGE(PG8_SB(0, 1), cB + hstep, voffB); PG8_STAGE(PG8_SA(0, 0), cA, voffA); PG8_STAGE(PG8_SA(0, 1), cA + hstep, voffA);
        if (wr == 1) PG8_BAR;
        PG8_WAIT_V(2); PG8_BAR;
        PG8_STAGE(PG8_SB(1, 0), cB + kstep, voffB); PG8_STAGE(PG8_SA(1, 0), cA + kstep, voffA); PG8_STAGE(PG8_SB(1, 1), cB + hstep + kstep, voffB);
        PG8_WAIT_V(6); PG8_BAR;
    } else {
        PG8_STAGE(PG8_SB(0, 0), cB, voffB); PG8_STAGE(PG8_SA(0, 0), cA, voffA); PG8_STAGE(PG8_SB(0, 1), cB + hstep, voffB); PG8_STAGE(PG8_SA(0, 1), cA + hstep, voffA);
        if (wr == 1) PG8_BAR;
        PG8_WAIT_V(4); PG8_BAR;
        PG8_STAGE(PG8_SB(1, 0), cB + kstep, voffB); PG8_STAGE(PG8_SA(1, 0), cA + kstep, voffA); PG8_STAGE(PG8_SB(1, 1), cB + hstep + kstep, voffB);
        PG8_WAIT_V(6); PG8_BAR;
    }
    for (;;) {
        const bool has_next = S.next(ui + 1, nxt);
        const char* nA = has_next ? (const char*)g.A + (size_t)nxt.pm * tstep : cA; const char* nB = has_next ? (const char*)g.Bt + (size_t)nxt.pn * tstep : cB;
        for (int t = 0; t < nt; t += 2) {
            const bool last = (t == nt - 2);
            const char* a1 = cA + (size_t)(t + 1) * kstep;
            const char* a2 = last ? nA : cA + (size_t)(t + 2) * kstep; const char* b2 = last ? nB : cB + (size_t)(t + 2) * kstep;
            const char* a3 = a2 + kstep; const char* b3 = b2 + kstep;
            if (last && has_next) S.a_ready(nxt);
            if constexpr (SP2) {
            PG8_LDB(B0, 0, 0); PG8_LDB(B1, 0, 1); PG8_SCHED; PG8_LDA(At, 0, 0); PG8_STAGE(PG8_SA(1, 1), a1 + hstep, voffA);
            PG8_WAIT_V(8); PG8_WAIT_L(0); PG8_BAR; PG8_MMA(0, 0, At, B0); PG8_MMA(0, 1, At, B1); PG8_BAR; PG8_SCHED;
            PG8_LDA(At, 0, 1); PG8_STAGE(PG8_SB(0, 0), b2, voffB); PG8_STAGE(PG8_SB(0, 1), b2 + hstep, voffB); PG8_STAGE(PG8_SA(0, 0), a2, voffA);
            PG8_WAIT_V(8); PG8_WAIT_L(0); PG8_BAR; PG8_MMA(1, 0, At, B0); PG8_MMA(1, 1, At, B1); PG8_BAR; PG8_SCHED;
            PG8_LDB(B0, 1, 0); PG8_LDB(B1, 1, 1); PG8_SCHED; PG8_LDA(At, 1, 0); PG8_STAGE(PG8_SA(0, 1), a2 + hstep, voffA);
            PG8_WAIT_V(8); PG8_WAIT_L(0); PG8_BAR; PG8_MMA(0, 0, At, B0); PG8_MMA(0, 1, At, B1); PG8_BAR; PG8_SCHED;
            PG8_LDA(At, 1, 1); PG8_STAGE(PG8_SB(1, 0), b3, voffB); PG8_STAGE(PG8_SB(1, 1), b3 + hstep, voffB); PG8_STAGE(PG8_SA(1, 0), a3, voffA);
            PG8_WAIT_V(8); PG8_WAIT_L(0); PG8_BAR; PG8_MMA(1, 0, At, B0); PG8_MMA(1, 1, At, B1); PG8_BAR; PG8_SCHED;
            } else {
            PG8_LDB(B0, 0, 0); PG8_SCHED; PG8_LDA(At, 0, 0); PG8_STAGE(PG8_SA(1, 1), a1 + hstep, voffA);
            PG8_WAIT_L(8); PG8_BAR; PG8_WAIT_L(0); PG8_MMA(0, 0, At, B0); PG8_BAR; PG8_SCHED;
            PG8_LDB(B1, 0, 1); PG8_STAGE(PG8_SB(0, 0), b2, voffB);
            PG8_BAR; PG8_WAIT_L(0); PG8_MMA(0, 1, At, B1); PG8_BAR;
            PG8_LDA(At, 0, 1); PG8_STAGE(PG8_SA(0, 0), a2, voffA);
            PG8_BAR; PG8_WAIT_L(0); PG8_MMA(1, 0, At, B0); PG8_BAR; PG8_SCHED;
            PG8_STAGE(PG8_SB(0, 1), b2 + hstep, voffB);
            PG8_WAIT_V(6); PG8_BAR; PG8_MMA(1, 1, At, B1); PG8_BAR;
            PG8_LDB(B0, 1, 0); PG8_SCHED; PG8_LDA(At, 1, 0); PG8_STAGE(PG8_SA(0, 1), a2 + hstep, voffA);
            PG8_WAIT_L(8); PG8_BAR; PG8_WAIT_L(0); PG8_MMA(0, 0, At, B0); PG8_BAR; PG8_SCHED;
            PG8_LDB(B1, 1, 1); PG8_STAGE(PG8_SB(1, 0), b3, voffB);
            PG8_BAR; PG8_WAIT_L(0); PG8_MMA(0, 1, At, B1); PG8_BAR;
            PG8_LDA(At, 1, 1); PG8_STAGE(PG8_SA(1, 0), a3, voffA);
            PG8_BAR; PG8_WAIT_L(0); PG8_MMA(1, 0, At, B0); PG8_BAR; PG8_SCHED;
            PG8_STAGE(PG8_SB(1, 1), b3 + hstep, voffB);
            PG8_WAIT_V(6); PG8_BAR; PG8_MMA(1, 1, At, B1); PG8_BAR;
            }
        }
        if constexpr (ALIGN_EPI) { if (wr == 0) PG8_BAR; }
        if constexpr (!Epi::AFTER_DRAIN) { E(acc, cur, wr, wc, fr, fq); S.done(cur); }
        if (!has_next) break;
#pragma unroll
        for (int a = 0; a < 2; ++a)
#pragma unroll
            for (int b = 0; b < 2; ++b)
#pragma unroll
                for (int m = 0; m < 4; ++m)
#pragma unroll
                    for (int n = 0; n < 2; ++n) acc[a][b][m][n] = (f32x4){0.f, 0.f, 0.f, 0.f};
        cur = nxt; cA = nA; cB = nB; ++ui;
        if constexpr (ALIGN_EPI) { if (wr == 1) PG8_BAR; }
    }
    PG8_WAIT_V(0);
    if constexpr (!ALIGN_EPI) { if (wr == 0) PG8_BAR; }
    PG8_BAR;
    if constexpr (Epi::AFTER_DRAIN) { E.fused(acc, cur, wr, wc, fr, fq, lds, wid, lane); S.done(cur); }
#undef PG8_SA
#undef PG8_SB
#undef PG8_STAGE
#undef PG8_LDA
#undef PG8_LDB
#undef PG8_MMA
#undef PG8_WAIT_V
#undef PG8_WAIT_L
#undef PG8_BAR
#undef PG8_SCHED
}
}

#define LAS __attribute__((address_space(3)))
#define DI __device__ __forceinline__
typedef unsigned short bf16_t;
typedef short bf16x8 __attribute__((ext_vector_type(8)));
typedef short s16x4 __attribute__((ext_vector_type(4)));
typedef float f32x4 __attribute__((ext_vector_type(4)));
typedef float f32x16 __attribute__((ext_vector_type(16)));
typedef unsigned u32x4 __attribute__((ext_vector_type(4)));
typedef unsigned u32x2 __attribute__((ext_vector_type(2)));
typedef float f32x2_t __attribute__((ext_vector_type(2)));
typedef __bf16 bf16x2_t __attribute__((ext_vector_type(2)));

constexpr int T = 16384, DM = 1024, DFF = 2816, SEQ = 4096, NB = 4;
constexpr float C2 = 0.125f * 1.4426950408889634f;
constexpr float LOG2E = 1.4426950408889634f;
constexpr float EPS = 1e-6f;
constexpr int NTHREADS = 512, NWAVES = 8;
constexpr int LDS_BYTES = 131072 + 256;
constexpr int LDS_MISC = 131072;

constexpr size_t al256(size_t x) { return (x + 255) & ~(size_t)255; }
constexpr size_t SZ_F1IN = (size_t)7168 * 1024 * 2, SZ_F2IN = (size_t)5632 * 1024 * 2, SZ_FOUT = (size_t)1024 * 2816 * 2, SZ_SQ = (size_t)1024 * 1024 * 2, SZ_GLU = (size_t)768 * 768 * 2;
constexpr size_t WS_CTL = 0;
constexpr size_t WS_BAR = 4096;
constexpr size_t WS_ZERO_BYTES = 4096 + 16384;
constexpr size_t WS_F1IN = WS_ZERO_BYTES;
constexpr size_t WS_F2IN = WS_F1IN + 4 * SZ_F1IN;
constexpr size_t WS_F1OUT = WS_F2IN + 4 * SZ_F2IN;
constexpr size_t WS_F2OUT = WS_F1OUT + 4 * SZ_FOUT;
constexpr size_t WS_MIXIN = WS_F2OUT + 4 * SZ_FOUT;
constexpr size_t WS_MIXOUT = WS_MIXIN + 4 * SZ_SQ;
constexpr size_t WS_GLU = WS_MIXOUT + 4 * SZ_SQ;
constexpr size_t WS_MEMKVW = WS_GLU + 2 * SZ_GLU;
constexpr size_t WS_XB = WS_MEMKVW + (size_t)2048 * 1024 * 2;
constexpr size_t WS_PART = WS_XB + (size_t)T * 1024 * 2;
constexpr size_t WS_ROPE = WS_PART + (size_t)T * 16 * 4;
constexpr size_t WS_MEMNB = WS_ROPE + (size_t)T * 16 * 4;
constexpr size_t WS_MKV = WS_MEMNB + (size_t)1024 * 1024 * 2;
constexpr size_t WS_KBUF = WS_MKV + (size_t)1024 * 2048 * 2;
constexpr size_t WS_VT = WS_KBUF + (size_t)T * 768 * 2;
constexpr size_t WS_S5A = WS_VT + (size_t)T * 768 * 2;
constexpr size_t WS_S5AL = WS_S5A + 2 * 48 * 128 * 4;
constexpr size_t WS_S5B = WS_S5AL + 2 * 48 * 128 * 4;
constexpr size_t WS_S5C = WS_S5B + 2 * 48 * 128 * 16 * 2;
constexpr size_t WS_S5END = WS_S5C + 2 * 48 * 16 * 128 * 2;
constexpr size_t WS_ACT = al256(WS_S5END + (size_t)4 * 64 * 48 * 128 * 4);
constexpr size_t WS_PROJ = WS_ACT;
constexpr size_t WS_MIXCAT = WS_ACT + (size_t)T * 1024 * 2;
constexpr size_t WS_YBUF = WS_MIXCAT + (size_t)T * 1024 * 2;
constexpr size_t WS_END = WS_ACT + (size_t)T * 2816 * 2;
static_assert(WS_YBUF + (size_t)T * 768 * 2 <= WS_END, "overlay");

struct Params { const float* in[31]; float* out; unsigned char* ws; int ph_lo, ph_hi; };

DI unsigned pkbf(float lo, float hi) { f32x2_t v = {lo, hi}; bf16x2_t b = __builtin_convertvector(v, bf16x2_t); return __builtin_bit_cast(unsigned, b); }
DI float bflo(unsigned w) { return __uint_as_float(w << 16); }
DI float bfhi(unsigned w) { return __uint_as_float(w & 0xffff0000u); }
DI float wave_sum(float v) {
#pragma unroll
    for (int o = 1; o < 64; o <<= 1) v += __shfl_xor(v, o);
    return v;
}
DI float ex2(float x) { return __builtin_amdgcn_exp2f(x); }
DI float rcpf(float x) { return __builtin_amdgcn_rcpf(x); }
DI float xor32_max(float v) { const auto r_ = __builtin_amdgcn_permlane32_swap(__float_as_uint(v), __float_as_uint(v), false, false); return fmaxf(__uint_as_float(r_[0]), __uint_as_float(r_[1])); }
DI float xor32_sum(float v) { const auto r_ = __builtin_amdgcn_permlane32_swap(__float_as_uint(v), __float_as_uint(v), false, false); return __uint_as_float(r_[0]) + __uint_as_float(r_[1]); }
DI int crow(int i, int h) { return (i & 3) + 8 * (i >> 2) + 4 * h; }
#define MFMA32(a, b, c) __builtin_amdgcn_mfma_f32_32x32x16_bf16((a), (b), (c), 0, 0, 0)
#define MFMA16(a, b, c) __builtin_amdgcn_mfma_f32_16x16x32_bf16((a), (b), (c), 0, 0, 0)

DI float row_rstd(const float* part, int row, int fq) {
    const f32x4 p = *(const f32x4*)(part + (size_t)row * 16 + 4 * fq);
    float s = (p[0] + p[1]) + (p[2] + p[3]);
    s += __shfl_xor(s, 16); s += __shfl_xor(s, 32);
    return rsqrtf(s * (1.0f / 1024.0f) + EPS);
}
DI u32x4 pack8(const f32x4 a, const f32x4 b) { u32x4 w; w.x = pkbf(a[0], a[1]); w.y = pkbf(a[2], a[3]); w.z = pkbf(b[0], b[1]); w.w = pkbf(b[2], b[3]); return w; }

DI void rope8(f32x4& v0, f32x4& v1, const float* rope, int row, int fq) {
    const f32x4 c0 = *(const f32x4*)(rope + (size_t)row * 16), c1 = *(const f32x4*)(rope + (size_t)row * 16 + 4);
    const f32x4 s0 = *(const f32x4*)(rope + (size_t)row * 16 + 8), s1 = *(const f32x4*)(rope + (size_t)row * 16 + 12);
    f32x4 p0, p1;
#pragma unroll
    for (int e = 0; e < 4; ++e) { p0[e] = __shfl_xor(v0[e], 16); p1[e] = __shfl_xor(v1[e], 16); }
    if (fq < 2) {
        const float sg = (fq == 0) ? -1.f : 1.f;
        v0 = v0 * c0 + sg * (p0 * s0); v1 = v1 * c1 + sg * (p1 * s1);
    }
}

struct EpiSwiglu {
    static constexpr bool PERM = true, AFTER_DRAIN = false;
    bf16_t* act; const float* part; bf16_t* kout; bf16_t* vtout; const float* rope;
    DI void operator()(const f32x4 (&acc)[2][2][4][2], const pg8::Unit& u, int wr, int wc, int fr, int fq) const {
        const int row0 = u.pm * 256 + wr * 64 + fr;
        if (u.pn < 22) {
            const int col = u.pn * 128 + wc * 32 + 8 * fq;
#pragma unroll
            for (int ai = 0; ai < 2; ++ai)
#pragma unroll
                for (int m = 0; m < 4; ++m) {
                    const int row = row0 + ai * 128 + m * 16; const float rs = row_rstd(part, row, fq);
                    f32x4 o[2];
#pragma unroll
                    for (int n = 0; n < 2; ++n) {
                        const f32x4 g = acc[ai][0][m][n] * rs, up = acc[ai][1][m][n] * rs;
#pragma unroll
                        for (int e = 0; e < 4; ++e) o[n][e] = g[e] * up[e] * rcpf(1.0f + ex2(-g[e] * LOG2E));
                    }
                    *(u32x4*)(act + (size_t)row * DFF + col) = pack8(o[0], o[1]);
                }
        } else {
            const int t = u.pn - 22;
#pragma unroll
            for (int ai = 0; ai < 2; ++ai)
#pragma unroll
                for (int m = 0; m < 4; ++m) {
                    const int row = row0 + ai * 128 + m * 16; const float rs = row_rstd(part, row, fq);
#pragma unroll
                    for (int bj = 0; bj < 2; ++bj) {
                        f32x4 v0 = acc[ai][bj][m][0] * rs, v1 = acc[ai][bj][m][1] * rs;
                        if (t < 3) {
                            if ((wc & 1) == 0) rope8(v0, v1, rope, row, fq);
                            *(u32x4*)(kout + (size_t)row * 768 + t * 256 + bj * 128 + wc * 32 + 8 * fq) = pack8(v0, v1);
                        } else {
                            const int hd = (t - 3) * 2 + bj, dv0 = wc * 32 + 8 * fq, b = row >> 12, s = row & 4095;
                            bf16_t* vp = vtout + ((size_t)(b * 6 + hd) * 128 + dv0) * 4096 + s;
                            const u32x4 w = pack8(v0, v1);
#pragma unroll
                            for (int e = 0; e < 4; ++e) { vp[(size_t)(2 * e) * 4096] = (bf16_t)(w[e] & 0xffffu); vp[(size_t)(2 * e + 1) * 4096] = (bf16_t)(w[e] >> 16); }
                        }
                    }
                }
        }
    }
};
struct EpiResid {
    static constexpr bool PERM = true, AFTER_DRAIN = false;
    float* xf; bf16_t* xb; float* part; float alpha;
    DI void operator()(const f32x4 (&acc)[2][2][4][2], const pg8::Unit& u, int wr, int wc, int fr, int fq) const {
        const int row0 = u.pm * 256 + wr * 64 + fr, col = u.pn * 256 + wc * 32 + 8 * fq;
#pragma unroll
        for (int ai = 0; ai < 2; ++ai) {
            u32x4 pre[4][2];
#pragma unroll
            for (int m = 0; m < 4; ++m)
#pragma unroll
                for (int bj = 0; bj < 2; ++bj) pre[m][bj] = *(const u32x4*)(xb + (size_t)(row0 + ai * 128 + m * 16) * DM + col + bj * 128);
#pragma unroll
            for (int m = 0; m < 4; ++m) {
                const int row = row0 + ai * 128 + m * 16; float ss = 0.f;
#pragma unroll
                for (int bj = 0; bj < 2; ++bj) {
                    const u32x4 w = pre[m][bj];
                    const f32x4 x0 = {bflo(w[0]), bfhi(w[0]), bflo(w[1]), bfhi(w[1])}, x1 = {bflo(w[2]), bfhi(w[2]), bflo(w[3]), bfhi(w[3])};
                    const f32x4 o0 = x0 + alpha * acc[ai][bj][m][0], o1 = x1 + alpha * acc[ai][bj][m][1];
                    ss += (o0[0] * o0[0] + o0[1] * o0[1]) + (o0[2] * o0[2] + o0[3] * o0[3]) + (o1[0] * o1[0] + o1[1] * o1[1]) + (o1[2] * o1[2] + o1[3] * o1[3]);
                    if (xf) { float* xp = xf + (size_t)row * DM + col + bj * 128; *(f32x4*)xp = o0; *(f32x4*)(xp + 4) = o1; }
                    else *(u32x4*)(xb + (size_t)row * DM + col + bj * 128) = pack8(o0, o1);
                }
                ss += __shfl_xor(ss, 16); ss += __shfl_xor(ss, 32);
                if (fq == 0) part[(size_t)row * 16 + u.pn * 4 + wc] = ss;
            }
        }
    }
};
struct EpiProj {
    static constexpr bool PERM = true, AFTER_DRAIN = false;
    bf16_t* proj; const float* part; const float* rope; int attn;
    DI void operator()(const f32x4 (&acc)[2][2][4][2], const pg8::Unit& u, int wr, int wc, int fr, int fq) const {
        const int row0 = u.pm * 256 + wr * 64 + fr;
        const float sc = (attn || u.pn == 3) ? C2 : 1.0f;
        const bool dorope = attn && u.pn < 3 && (wc & 1) == 0;
#pragma unroll
        for (int ai = 0; ai < 2; ++ai)
#pragma unroll
            for (int m = 0; m < 4; ++m) {
                const int row = row0 + ai * 128 + m * 16; const float rs = row_rstd(part, row, fq) * sc;
#pragma unroll
                for (int bj = 0; bj < 2; ++bj) {
                    f32x4 v0 = acc[ai][bj][m][0] * rs, v1 = acc[ai][bj][m][1] * rs;
                    if (dorope) rope8(v0, v1, rope, row, fq);
                    *(u32x4*)(proj + (size_t)row * DM + u.pn * 256 + bj * 128 + wc * 32 + 8 * fq) = pack8(v0, v1);
                }
            }
    }
};
struct EpiGlu {
    static constexpr bool PERM = true, AFTER_DRAIN = false;
    const bf16_t* y; bf16_t* outp;
    DI void operator()(const f32x4 (&acc)[2][2][4][2], const pg8::Unit& u, int wr, int wc, int fr, int fq) const {
        const int row0 = u.pm * 256 + wr * 64 + fr;
#pragma unroll
        for (int ai = 0; ai < 2; ++ai)
#pragma unroll
            for (int m = 0; m < 4; ++m) {
                const int row = row0 + ai * 128 + m * 16;
#pragma unroll
                for (int bj = 0; bj < 2; ++bj) {
                    const int col = u.pn * 256 + bj * 128 + wc * 32 + 8 * fq;
                    const u32x4 yv = *(const u32x4*)(y + (size_t)row * 768 + col);
                    f32x4 o0, o1;
#pragma unroll
                    for (int e = 0; e < 2; ++e) {
                        o0[2 * e] = bflo(yv[e]) * rcpf(1.0f + ex2(-acc[ai][bj][m][0][2 * e] * LOG2E));
                        o0[2 * e + 1] = bfhi(yv[e]) * rcpf(1.0f + ex2(-acc[ai][bj][m][0][2 * e + 1] * LOG2E));
                        o1[2 * e] = bflo(yv[2 + e]) * rcpf(1.0f + ex2(-acc[ai][bj][m][1][2 * e] * LOG2E));
                        o1[2 * e + 1] = bfhi(yv[2 + e]) * rcpf(1.0f + ex2(-acc[ai][bj][m][1][2 * e + 1] * LOG2E));
                    }
                    *(u32x4*)(outp + (size_t)row * DM + col) = pack8(o0, o1);
                }
            }
    }
};
struct EpiPlain {
    static constexpr bool PERM = true, AFTER_DRAIN = false;
    bf16_t* O; int ldc;
    DI void operator()(const f32x4 (&acc)[2][2][4][2], const pg8::Unit& u, int wr, int wc, int fr, int fq) const {
        const int row0 = u.pm * 256 + wr * 64 + fr;
#pragma unroll
        for (int ai = 0; ai < 2; ++ai)
#pragma unroll
            for (int m = 0; m < 4; ++m)
#pragma unroll
                for (int bj = 0; bj < 2; ++bj)
                    *(u32x4*)(O + (size_t)(row0 + ai * 128 + m * 16) * ldc + u.pn * 256 + bj * 128 + wc * 32 + 8 * fq) = pack8(acc[ai][bj][m][0], acc[ai][bj][m][1]);
    }
};
struct OffsetOrder {
    pg8::StaticOrder so; bool valid;
    DI void init(int M, int N, int G, int c) { valid = c >= 0; so.init(M, N, G, c < 0 ? 0 : c); }
    DI bool next(int i, pg8::Unit& u) const { return valid && so.next(i, u); }
    DI void a_ready(const pg8::Unit&) const {}
    DI void done(const pg8::Unit&) const {}
};

struct Job { const float* src; const float* gain; bf16_t* dst; int K, N, mode, start; };

DI void transpose_item(const float* W, const float* gain, bf16_t* dst, int K, int N, int mode, LAS float* scr, int item, int lane) {
    const int nblk = N / 32, kb = item / nblk, nb = item - kb * nblk, k0 = 64 * kb, n0 = 32 * nb;
    float wv[32];
    const float* wp = W + (size_t)(k0 + (lane >> 5)) * N + n0 + (lane & 31);
#pragma unroll
    for (int i = 0; i < 32; ++i) wv[i] = __builtin_nontemporal_load(wp + (size_t)(2 * i) * N);
    if (gain) {
#pragma unroll
        for (int i = 0; i < 32; ++i) wv[i] *= gain[k0 + 2 * i + (lane >> 5)];
    }
#pragma unroll
    for (int i = 0; i < 32; ++i) scr[(2 * i + (lane >> 5)) * 33 + (lane & 31)] = wv[i];
    asm volatile("s_waitcnt lgkmcnt(0)" ::: "memory");
    int drow0 = n0;
    if (mode == 1) drow0 = (n0 < DFF) ? (n0 / 128) * 256 + (n0 % 128) : ((n0 - DFF) / 128) * 256 + 128 + ((n0 - DFF) % 128);
    const int c = lane & 7;
#pragma unroll
    for (int j = 0; j < 4; ++j) {
        const int n = (lane >> 3) + 8 * j; const LAS float* s = scr + (8 * c) * 33 + n;
        u32x4 o; o.x = pkbf(s[0 * 33], s[1 * 33]); o.y = pkbf(s[2 * 33], s[3 * 33]); o.z = pkbf(s[4 * 33], s[5 * 33]); o.w = pkbf(s[6 * 33], s[7 * 33]);
        __builtin_nontemporal_store(o, (u32x4*)(dst + (size_t)(drow0 + n) * K + k0 + 8 * c));
    }
    asm volatile("s_waitcnt lgkmcnt(0)" ::: "memory");
}

DI void convert_item(const Params& P, unsigned char* ws, int it, LAS float* scr, int lane) {
    const float* src; const float* gain = nullptr; unsigned char* dst; int K = 1024, N = 1024, mode = 0, item;
    if (it < 38912) {
        const int l = it / 9728, r = it - l * 9728;
        if (r < 2816) { src = P.in[4] + (size_t)l * 1024 * 5632; gain = P.in[3] + l * 1024; dst = ws + WS_F1IN + l * SZ_F1IN; N = 5632; mode = 1; item = r; }
        else if (r < 4224) { src = P.in[5] + (size_t)l * 2816 * 1024; dst = ws + WS_F1OUT + l * SZ_FOUT; K = 2816; item = r - 2816; }
        else if (r < 4736) { src = P.in[7] + (size_t)l * 1024 * 1024; gain = P.in[6] + l * 1024; dst = ws + WS_MIXIN + l * SZ_SQ; item = r - 4224; }
        else if (r < 5248) { src = P.in[8] + (size_t)l * 1024 * 1024; dst = ws + WS_MIXOUT + l * SZ_SQ; item = r - 4736; }
        else if (r < 8064) { src = P.in[12] + (size_t)l * 1024 * 5632; gain = P.in[11] + l * 1024; dst = ws + WS_F2IN + l * SZ_F2IN; N = 5632; mode = 1; item = r - 5248; }
        else if (r < 9472) { src = P.in[13] + (size_t)l * 2816 * 1024; dst = ws + WS_F2OUT + l * SZ_FOUT; K = 2816; item = r - 8064; }
        else { src = P.in[10] + (size_t)l * 1024 * 512; dst = ws + WS_MEMKVW + (size_t)l * 512 * 1024 * 2; N = 512; item = r - 9472; }
    } else if (it < 39488) {
        const int j = (it - 38912) / 288; item = (it - 38912) - 288 * j;
        src = P.in[22] + (size_t)j * 768 * 768; dst = ws + WS_GLU + j * SZ_GLU; K = 768; N = 768;
    } else { item = it - 39488; src = P.in[24]; gain = P.in[23]; dst = ws + WS_F1IN + 2 * SZ_F1IN + (size_t)5632 * 1024 * 2; N = 1536; }
    transpose_item(src, gain, (bf16_t*)dst, K, N, mode, scr, item, lane);
}

DI void prep_phase(const Params& P, LAS unsigned char* lds, const int tid, const int bid) {
    const int lane = tid & 63, wave = tid >> 6;
    const int gw = bid * NWAVES + wave, NGW = gridDim.x * NWAVES;
    unsigned char* ws = P.ws;
    {
        LAS float* scr = (LAS float*)(lds + wave * 8448);
        const int gwu = __builtin_amdgcn_readfirstlane(gw);
#pragma unroll 1
        for (int p = gwu; p < 11840; p += NGW) {
            int it;
            if (p < 9472) it = p;
            else if (p < 10496) { const int q = p - 9472; it = (q >> 8) * 9728 + 9472 + (q & 255); }
            else it = 38912 + (p - 10496);
            convert_item(P, ws, it, scr, lane);
        }
    }
    {
        const float* x = P.in[0]; bf16_t* xb = (bf16_t*)(ws + WS_XB); float* part = (float*)(ws + WS_PART);
        for (int row = gw; row < T; row += NGW) {
            f32x4 v[4]; float ss = 0.f;
#pragma unroll
            for (int j = 0; j < 4; ++j) { v[j] = *(const f32x4*)(x + (size_t)row * DM + 4 * lane + 256 * j); ss += (v[j][0] * v[j][0] + v[j][1] * v[j][1]) + (v[j][2] * v[j][2] + v[j][3] * v[j][3]); }
            ss = wave_sum(ss);
#pragma unroll
            for (int j = 0; j < 4; ++j) {
                u32x2 w; w.x = pkbf(v[j][0], v[j][1]); w.y = pkbf(v[j][2], v[j][3]);
                *(u32x2*)(xb + (size_t)row * DM + 4 * lane + 256 * j) = w;
            }
            if (lane < 16) part[(size_t)row * 16 + lane] = (lane == 0) ? ss : 0.f;
        }
    }
    {
        const float* mem = P.in[1]; const float* g = P.in[9]; bf16_t* mn = (bf16_t*)(ws + WS_MEMNB);
        for (int row = gw; row < 1024; row += NGW) {
            f32x4 v[4]; float ss = 0.f;
#pragma unroll
            for (int j = 0; j < 4; ++j) { v[j] = *(const f32x4*)(mem + (size_t)row * DM + 4 * lane + 256 * j); ss += (v[j][0] * v[j][0] + v[j][1] * v[j][1]) + (v[j][2] * v[j][2] + v[j][3] * v[j][3]); }
            const float rs = rsqrtf(wave_sum(ss) * (1.0f / 1024.0f) + EPS);
#pragma unroll
            for (int j = 0; j < 4; ++j) {
                const f32x4 gg = *(const f32x4*)(g + 4 * lane + 256 * j); const f32x4 o = v[j] * rs * gg;
                u32x2 w; w.x = pkbf(o[0], o[1]); w.y = pkbf(o[2], o[3]);
                *(u32x2*)(mn + (size_t)row * DM + 4 * lane + 256 * j) = w;
            }
        }
    }
    const int gt = bid * NTHREADS + tid, NGT = gridDim.x * NTHREADS;
    {
        const int* pos = (const int*)P.in[2]; float* rope = (float*)(ws + WS_ROPE);
        for (int i = gt; i < T * 8; i += NGT) {
            const int row = i >> 3, f = i & 7;
            const double invs[8] = {1.0, 0.19392274474868576, 0.03760603093086393, 0.007292664737217109, 0.001414213562373095, 0.0002742481756762073, 5.318295896944988e-05, 1.031338537721246e-05};
            double inv = invs[0];
#pragma unroll
            for (int q = 1; q < 8; ++q) inv = (f == q) ? invs[q] : inv;
            const double ang = (double)pos[row] * inv;
            const double k = __builtin_rint(ang * 0.15915494309189535);
            const float rr = (float)(ang - k * 6.283185307179586);
            rope[(size_t)row * 16 + f] = cosf(rr); rope[(size_t)row * 16 + 8 + f] = sinf(rr);
        }
    }
    {
        float* sa = (float*)(ws + WS_S5A); float* sal = (float*)(ws + WS_S5AL); bf16_t* sb = (bf16_t*)(ws + WS_S5B); bf16_t* sc = (bf16_t*)(ws + WS_S5C);
        for (int i = gt; i < 2 * 48 * 64; i += NGT) {
            const int jg = i >> 6, p = i & 63;
            const float dt = expf(P.in[16][jg]);
            const float lr = P.in[14][i], li = P.in[15][i];
            const float mag = expf(lr * dt);
            const float abr = mag * cosf(li * dt), abi = mag * sinf(li * dt);
            const float den = lr * lr + li * li, nr = abr - 1.0f, ni = abi;
            const float fr = (nr * lr + ni * li) / den, fi = (ni * lr - nr * li) / den;
            sa[jg * 128 + p] = abr; sa[jg * 128 + 64 + p] = abi;
            float pr = abr, pi = abi;
#pragma unroll
            for (int q = 0; q < 6; ++q) { const float tr = pr * pr - pi * pi, ti = 2.0f * pr * pi; pr = tr; pi = ti; }
            sal[jg * 128 + p] = pr; sal[jg * 128 + 64 + p] = pi;
            const float* br = P.in[17] + (size_t)i * 16; const float* bi = P.in[18] + (size_t)i * 16;
#pragma unroll 2
            for (int c = 0; c < 16; c += 2) {
                const float r0 = fr * br[c] - fi * bi[c], r1 = fr * br[c + 1] - fi * bi[c + 1];
                const float i0 = fr * bi[c] + fi * br[c], i1 = fr * bi[c + 1] + fi * br[c + 1];
                *(unsigned*)(sb + ((size_t)jg * 128 + p) * 16 + c) = pkbf(r0, r1);
                *(unsigned*)(sb + ((size_t)jg * 128 + 64 + p) * 16 + c) = pkbf(i0, i1);
            }
            const float* cr = P.in[19] + (size_t)jg * 16 * 64; const float* ci = P.in[20] + (size_t)jg * 16 * 64;
#pragma unroll 2
            for (int co = 0; co < 16; ++co)
                *(unsigned*)(sc + ((size_t)jg * 16 + co) * 128 + 2 * p) = pkbf(cr[co * 64 + p], -ci[co * 64 + p]);
        }
    }
    if (bid == 0 && tid < 2) {
        const int j = tid; float s1 = 0.f, s2 = 0.f;
        for (int d = 0; d < 64; ++d) { s1 += P.in[25][j * 64 + d] * P.in[26][j * 64 + d]; s2 += P.in[27][j * 64 + d] * P.in[28][j * 64 + d]; }
        const float li = 0.8f - 0.6f * expf(-0.3f * (float)(2 + j));
        float* cf = (float*)(ws + WS_CTL);
        cf[16 + 2 * j] = expf(s1) - expf(s2) + li; cf[17 + 2 * j] = 1.0f - li;
    }
    if (bid == 0 && tid < 32) ((unsigned*)(ws + WS_CTL))[64 + tid] = 0u;
}

constexpr int MVT_LD = 260;
DI void mem_attn_task(const bf16_t* proj, const bf16_t* mkv, bf16_t* mixcat, int task, LAS unsigned char* lds, int tid) {
    const int wave = tid >> 6, lane = tid & 63, r = lane & 31, h = lane >> 5;
    const int b = task >> 6, hm = (task >> 4) & 3, qb = task & 15;
    const bf16_t* ksrc = mkv + (size_t)(b * 256) * 2048 + hm * 64;
    const bf16_t* vsrc = ksrc + 256;
    LAS bf16_t* vt = (LAS bf16_t*)lds;
#pragma unroll
    for (int i = 0; i < 4; ++i) {
        const int id = tid + 512 * i, m = id >> 3, c = id & 7;
        const u32x4 w = *(const u32x4*)(vsrc + (size_t)m * 2048 + c * 8);
#pragma unroll
        for (int e = 0; e < 4; ++e) { vt[(8 * c + 2 * e) * MVT_LD + m] = (bf16_t)(w[e] & 0xffffu); vt[(8 * c + 2 * e + 1) * MVT_LD + m] = (bf16_t)(w[e] >> 16); }
    }
    LAS unsigned char* kt = lds + 64 * MVT_LD * 2;
#pragma unroll
    for (int i = 0; i < 4; ++i) {
        const int id = tid + 512 * i, m = id >> 3, c = id & 7;
        *(LAS u32x4*)(kt + m * 144 + c * 16) = *(const u32x4*)(ksrc + (size_t)m * 2048 + c * 8);
    }
    __syncthreads();
    const int row = b * SEQ + qb * 256 + wave * 32 + r;
    bf16x8 qf[4];
#pragma unroll
    for (int s = 0; s < 4; ++s) qf[s] = *(const bf16x8*)(proj + (size_t)row * DM + 768 + hm * 64 + 16 * s + 8 * h);
    f32x16 sacc[8];
#pragma unroll
    for (int kb = 0; kb < 8; ++kb) {
#pragma unroll
        for (int i = 0; i < 16; ++i) sacc[kb][i] = 0.f;
#pragma unroll
        for (int s = 0; s < 4; ++s) {
            const bf16x8 kf = *(const LAS bf16x8*)(kt + (kb * 32 + r) * 144 + (16 * s + 8 * h) * 2);
            sacc[kb] = MFMA32(kf, qf[s], sacc[kb]);
        }
    }
    float mx = -INFINITY;
#pragma unroll
    for (int kb = 0; kb < 8; ++kb)
#pragma unroll
        for (int i = 0; i < 16; ++i) mx = fmaxf(mx, sacc[kb][i]);
    mx = fmaxf(mx, __shfl_xor(mx, 32));
    float l = 0.f;
#pragma unroll
    for (int kb = 0; kb < 8; ++kb)
#pragma unroll
        for (int i = 0; i < 16; ++i) { const float p = ex2(sacc[kb][i] - mx); sacc[kb][i] = p; l += p; }
    l += __shfl_xor(l, 32);
    f32x16 oacc[2];
#pragma unroll
    for (int db = 0; db < 2; ++db)
#pragma unroll
        for (int i = 0; i < 16; ++i) oacc[db][i] = 0.f;
#pragma unroll
    for (int kb = 0; kb < 8; ++kb)
#pragma unroll
        for (int s2 = 0; s2 < 2; ++s2) {
            u32x4 pw;
#pragma unroll
            for (int e = 0; e < 4; ++e) pw[e] = pkbf(sacc[kb][8 * s2 + 2 * e], sacc[kb][8 * s2 + 2 * e + 1]);
            const bf16x8 pb = __builtin_bit_cast(bf16x8, pw);
#pragma unroll
            for (int db = 0; db < 2; ++db) {
                const LAS bf16_t* vp = vt + (32 * db + r) * MVT_LD + 32 * kb + 16 * s2 + 4 * h;
                const s16x4 lo = *(const LAS s16x4*)vp, hi = *(const LAS s16x4*)(vp + 8);
                const bf16x8 va = __builtin_shufflevector(lo, hi, 0, 1, 2, 3, 4, 5, 6, 7);
                oacc[db] = MFMA32(va, pb, oacc[db]);
            }
        }
    const float inv = 1.0f / l;
    bf16_t* op = mixcat + (size_t)row * DM + 768 + hm * 64 + 4 * h;
#pragma unroll
    for (int db = 0; db < 2; ++db)
#pragma unroll
        for (int i4 = 0; i4 < 4; ++i4) {
            u32x2 w; w.x = pkbf(oacc[db][4 * i4] * inv, oacc[db][4 * i4 + 1] * inv); w.y = pkbf(oacc[db][4 * i4 + 2] * inv, oacc[db][4 * i4 + 3] * inv);
            *(u32x2*)(op + 32 * db + 8 * i4) = w;
        }
    __syncthreads();
}

constexpr int KT_LD = 272, VT_LD = 144, KT_BYTES = 64 * KT_LD, VT_BYTES = 128 * VT_LD;
DI void diff_attn_task(const bf16_t* proj, const bf16_t* kbuf, const bf16_t* vtb, bf16_t* mixcat, const float* subln, float lam, float oml, int task, LAS unsigned char* lds, int tid) {
    const int wave = tid >> 6, lane = tid & 63, r = lane & 31, h = lane >> 5, sub = wave >> 2, wq = wave & 3;
    const int qb = 31 - task / 24, rem = task % 24, b = rem / 6, hd = rem % 6;
    const int myq0 = qb * 128 + wq * 32, q = myq0 + r, row = b * SEQ + q;
    bf16x8 qf[4];
#pragma unroll
    for (int s = 0; s < 4; ++s) qf[s] = *(const bf16x8*)(proj + (size_t)row * DM + hd * 128 + sub * 64 + 16 * s + 8 * h);
    const int ntiles = 2 * (qb + 1);
    const int kr0 = tid >> 4, kc = tid & 15;
    const int vr0 = tid >> 3, vc = tid & 7;
    const bf16_t* kg = kbuf + (size_t)(b * SEQ + kr0) * 768 + hd * 128 + kc * 8;
    const bf16_t* vg = vtb + ((size_t)(b * 6 + hd) * 128 + vr0) * 4096 + vc * 8;
    u32x4 kreg[2], vreg[2];
#define DA_LOAD(j) do { _Pragma("unroll") for (int i_ = 0; i_ < 2; ++i_) { kreg[i_] = *(const u32x4*)(kg + (size_t)((j) * 64 + 32 * i_) * 768); vreg[i_] = *(const u32x4*)(vg + (size_t)(64 * i_) * 4096 + (j) * 64); } } while (0)
#define DA_WRITE(buf) do { _Pragma("unroll") for (int i_ = 0; i_ < 2; ++i_) { *(LAS u32x4*)(lds + (buf) * KT_BYTES + (kr0 + 32 * i_) * KT_LD + kc * 16) = kreg[i_]; \
        LAS unsigned char* vp_ = lds + 2 * KT_BYTES + (buf) * VT_BYTES + (vr0 + 64 * i_) * VT_LD + vc * 16; \
        u32x2 a_; a_.x = vreg[i_].x; a_.y = vreg[i_].y; u32x2 b_; b_.x = vreg[i_].z; b_.y = vreg[i_].w; *(LAS u32x2*)vp_ = a_; *(LAS u32x2*)(vp_ + 8) = b_; } } while (0)
#define DA_LOADK(j) do { _Pragma("unroll") for (int i_ = 0; i_ < 2; ++i_) kreg[i_] = *(const u32x4*)(kg + (size_t)((j) * 64 + 32 * i_) * 768); } while (0)
#define DA_LOADV(j) do { _Pragma("unroll") for (int i_ = 0; i_ < 2; ++i_) vreg[i_] = *(const u32x4*)(vg + (size_t)(64 * i_) * 4096 + (j) * 64); } while (0)
#define DA_WRITEK(slot) do { _Pragma("unroll") for (int i_ = 0; i_ < 2; ++i_) *(LAS u32x4*)(lds + (slot) * KT_BYTES + (kr0 + 32 * i_) * KT_LD + kc * 16) = kreg[i_]; } while (0)
#define DA_WRITEV(slot) do { _Pragma("unroll") for (int i_ = 0; i_ < 2; ++i_) { LAS unsigned char* vp_ = lds + 3 * KT_BYTES + (slot) * VT_BYTES + (vr0 + 64 * i_) * VT_LD + (vc >> 1) * 32 + (vc & 1) * 8; \
        u32x2 a_; a_.x = vreg[i_].x; a_.y = vreg[i_].y; u32x2 b_; b_.x = vreg[i_].z; b_.y = vreg[i_].w; *(LAS u32x2*)vp_ = a_; *(LAS u32x2*)(vp_ + 16) = b_; } } while (0)
#define DA_QK(S_, slot) do { const LAS unsigned char* kt_ = lds + (slot) * KT_BYTES; _Pragma("unroll") for (int kb = 0; kb < 2; ++kb) { _Pragma("unroll") for (int i = 0; i < 16; ++i) S_[kb][i] = 0.f; \
        _Pragma("unroll") for (int s_ = 0; s_ < 4; ++s_) { const bf16x8 kf = *(const LAS bf16x8*)(kt_ + (32 * kb + r) * KT_LD + (sub * 64 + 16 * s_ + 8 * h) * 2); S_[kb] = MFMA32(kf, qf[s_], S_[kb]); } } } while (0)
    DA_LOADK(0); DA_LOADV(0); DA_WRITEK(0); DA_WRITEV(0);
    DA_LOADK(1); DA_WRITEK(1);
    __syncthreads();
    f32x16 oacc[4];
#pragma unroll
    for (int db = 0; db < 4; ++db)
#pragma unroll
        for (int i = 0; i < 16; ++i) oacc[db][i] = 0.f;
    float mrun = -INFINITY, lrun = 0.f;
    f32x16 sA[2], sB[2];
    DA_QK(sA, 0);
    int ks1 = 1, ks2 = 2;
#define DA_STEP(SC, SN, j_) do { const int j = (j_); const int k0 = j * 64; \
        { const int jk = (j + 2 < ntiles) ? j + 2 : ntiles - 1, jv = (j + 1 < ntiles) ? j + 1 : ntiles - 1; DA_LOADK(jk); DA_LOADV(jv); } \
        const bool act = (k0 <= myq0 + 31), actn = (j + 1 < ntiles) && (k0 + 64 <= myq0 + 31); \
        if (actn) DA_QK(SN, ks1); \
        if (act) { \
            const LAS unsigned char* vt = lds + 3 * KT_BYTES + (j & 1) * VT_BYTES; \
            if (k0 + 63 > myq0) { \
                _Pragma("unroll") for (int kb = 0; kb < 2; ++kb) { _Pragma("unroll") for (int i = 0; i < 16; ++i) if (k0 + 32 * kb + crow(i, h) > q) SC[kb][i] = -INFINITY; } } \
            float mx = -INFINITY; \
            _Pragma("unroll") for (int kb = 0; kb < 2; ++kb) { _Pragma("unroll") for (int i = 0; i < 16; ++i) mx = fmaxf(mx, SC[kb][i]); } \
            mx = xor32_max(mx); \
            const float mnew = fmaxf(mrun, mx), alpha = ex2(mrun - mnew); \
            mrun = mnew; \
            SC[0] = SC[0] - mnew; SC[1] = SC[1] - mnew;                                     \
            _Pragma("unroll") for (int kb = 0; kb < 2; ++kb) { _Pragma("unroll") for (int i = 0; i < 16; ++i) SC[kb][i] = ex2(SC[kb][i]); } \
            { const f32x16 t16 = SC[0] + SC[1]; \
              const f32x4 t4 = (f32x4){t16[0], t16[1], t16[2], t16[3]} + (f32x4){t16[4], t16[5], t16[6], t16[7]} + (f32x4){t16[8], t16[9], t16[10], t16[11]} + (f32x4){t16[12], t16[13], t16[14], t16[15]}; \
              lrun = lrun * alpha + ((t4[0] + t4[1]) + (t4[2] + t4[3])); } \
            if (__any(alpha != 1.0f)) { _Pragma("unroll") for (int db = 0; db < 4; ++db) oacc[db] = oacc[db] * alpha; } \
            _Pragma("unroll") for (int kb = 0; kb < 2; ++kb) { _Pragma("unroll") for (int s2 = 0; s2 < 2; ++s2) { \
                u32x4 pw; \
                _Pragma("unroll") for (int e = 0; e < 4; ++e) pw[e] = pkbf(SC[kb][8 * s2 + 2 * e], SC[kb][8 * s2 + 2 * e + 1]); \
                const bf16x8 pb = __builtin_bit_cast(bf16x8, pw); \
                _Pragma("unroll") for (int db = 0; db < 4; ++db) { \
                    const bf16x8 va = *(const LAS bf16x8*)(vt + (32 * db + r) * VT_LD + (2 * kb + s2) * 32 + 16 * h); \
                    oacc[db] = MFMA32(va, pb, oacc[db]); } } } \
        } \
        DA_WRITEK(ks2); \
        DA_WRITEV((j + 1) & 1); \
        __syncthreads(); \
        ks1 = ks2; ks2 = (ks2 == 2) ? 0 : ks2 + 1; } while (0)
    for (int jj = 0; jj < ntiles; jj += 2) {
        DA_STEP(sA, sB, jj);
        DA_STEP(sB, sA, jj + 1);
    }
#undef DA_STEP
#undef DA_LOADK
#undef DA_LOADV
#undef DA_WRITEK
#undef DA_WRITEV
#undef DA_QK
#undef DA_LOAD
#undef DA_WRITE
    const float ltot = lrun + __shfl_xor(lrun, 32), inv = 1.0f / ltot;
    LAS float* xch = (LAS float*)lds;
    if (sub == 1) {
#pragma unroll
        for (int db = 0; db < 4; ++db)
#pragma unroll
            for (int i = 0; i < 16; ++i) xch[(wq * 64 + db * 16 + i) * 64 + lane] = oacc[db][i] * inv;
    }
    __syncthreads();
    if (sub == 0) {
        float ss = 0.f;
#pragma unroll
        for (int db = 0; db < 4; ++db)
#pragma unroll
            for (int i = 0; i < 16; ++i) { const float d = oacc[db][i] * inv - lam * xch[(wq * 64 + db * 16 + i) * 64 + lane]; oacc[db][i] = d; ss += d * d; }
        ss += __shfl_xor(ss, 32);
        const float rs = rsqrtf(ss * (1.0f / 128.0f) + EPS) * oml;
        bf16_t* op = mixcat + (size_t)row * DM + hd * 128 + 4 * h;
#pragma unroll
        for (int db = 0; db < 4; ++db)
#pragma unroll
            for (int i4 = 0; i4 < 4; ++i4) {
                const f32x4 g = *(const f32x4*)(subln + 32 * db + 8 * i4 + 4 * h);
                u32x2 w; w.x = pkbf(oacc[db][4 * i4] * rs * g[0], oacc[db][4 * i4 + 1] * rs * g[1]); w.y = pkbf(oacc[db][4 * i4 + 2] * rs * g[2], oacc[db][4 * i4 + 3] * rs * g[3]);
                *(u32x2*)(op + 32 * db + 8 * i4) = w;
            }
    }
    __syncthreads();
}

constexpr int HI_LD = 272;
template <int PASS>
DI void s5_task(const bf16_t* proj, const float* sa, const float* sal, const bf16_t* sb, const bf16_t* sc, const float* dvec, float* s5end, bf16_t* ybuf, int j, int task, LAS unsigned char* himg, int lane) {
    const int r = lane & 31, h = lane >> 5, fr = lane & 15, fq = lane >> 4;
    const int rg = task & 15, g = (task >> 4) % 48, b = (task >> 4) / 48;
    const int jg = j * 48 + g;
    float ar[2], ai[2], a2r[2], a2i[2], a3r[2], a3i[2], a4r[2], a4i[2];
#pragma unroll
    for (int pb = 0; pb < 2; ++pb) {
        ar[pb] = sa[jg * 128 + 32 * pb + r]; ai[pb] = sa[jg * 128 + 64 + 32 * pb + r];
        a2r[pb] = ar[pb] * ar[pb] - ai[pb] * ai[pb]; a2i[pb] = 2.0f * ar[pb] * ai[pb];
        a3r[pb] = a2r[pb] * ar[pb] - a2i[pb] * ai[pb]; a3i[pb] = a2r[pb] * ai[pb] + a2i[pb] * ar[pb];
        a4r[pb] = a2r[pb] * a2r[pb] - a2i[pb] * a2i[pb]; a4i[pb] = 2.0f * a2r[pb] * a2i[pb];
    }
    bf16x8 bfrag[4];
#pragma unroll
    for (int nt = 0; nt < 4; ++nt) bfrag[nt] = *(const bf16x8*)(sb + ((size_t)jg * 128 + 32 * nt + r) * 16 + 8 * h);
    bf16x8 cfrag[4]; f32x4 dv = {0.f, 0.f, 0.f, 0.f};
    if (PASS == 2) {
#pragma unroll
        for (int s = 0; s < 4; ++s) cfrag[s] = *(const bf16x8*)(sc + ((size_t)jg * 16 + fr) * 128 + 32 * s + 8 * fq);
        dv = *(const f32x4*)(dvec + j * 768 + g * 16 + 4 * fq);
    }
    float Ir[2] = {0.f, 0.f}, Ii[2] = {0.f, 0.f};
    if (PASS == 2) {
        float lr_[2], li_[2];
#pragma unroll
        for (int pb = 0; pb < 2; ++pb) { lr_[pb] = sal[jg * 128 + 32 * pb + r]; li_[pb] = sal[jg * 128 + 64 + 32 * pb + r]; }
#pragma unroll
        for (int pb = 0; pb < 2; ++pb) {
#pragma unroll
            for (int q2 = 0; q2 < 2; ++q2) { const float tr = lr_[pb] * lr_[pb] - li_[pb] * li_[pb], ti = 2.0f * lr_[pb] * li_[pb]; lr_[pb] = tr; li_[pb] = ti; }
        }
        const float* se = s5end + ((size_t)(b * 16) * 48 + g) * 128;
        for (int c = 0; c < rg; ++c) {
            const int cc = c;
            float sr[2], si[2];
#pragma unroll
            for (int pb = 0; pb < 2; ++pb) { sr[pb] = se[(size_t)cc * 48 * 128 + 32 * pb + r]; si[pb] = se[(size_t)cc * 48 * 128 + 64 + 32 * pb + r]; }
            if (c < rg) {
#pragma unroll
                for (int pb = 0; pb < 2; ++pb) {
                    const float nr = Ir[pb] * lr_[pb] - Ii[pb] * li_[pb] + sr[pb], ni = Ir[pb] * li_[pb] + Ii[pb] * lr_[pb] + si[pb];
                    Ir[pb] = nr; Ii[pb] = ni;
                }
            }
        }
    }
#pragma unroll 1
    for (int ck = 0; ck < 4; ++ck) {
        const int chunk = rg * 4 + ck, t0 = chunk * 64;
        const bf16x8 ufr0 = *(const bf16x8*)(proj + (size_t)(b * SEQ + t0 + r) * DM + g * 16 + 8 * h);
        const bf16x8 ufr1 = *(const bf16x8*)(proj + (size_t)(b * SEQ + t0 + 32 + r) * DM + g * 16 + 8 * h);
#pragma unroll 1
        for (int mt = 0; mt < 2; ++mt) {
            const bf16x8 ufr = mt ? ufr1 : ufr0;
            u32x2 uwp[2];
            if (PASS == 2) {
#pragma unroll
                for (int tb = 0; tb < 2; ++tb) uwp[tb] = *(const u32x2*)(proj + (size_t)(b * SEQ + t0 + 32 * mt + 16 * tb + fr) * DM + g * 16 + 4 * fq);
            }
            f32x16 x[4];
#pragma unroll
            for (int nt = 0; nt < 4; ++nt) {
#pragma unroll
                for (int i = 0; i < 16; ++i) x[nt][i] = 0.f;
                x[nt] = MFMA32(ufr, bfrag[nt], x[nt]);
            }
#pragma unroll
            for (int pb = 0; pb < 2; ++pb) {
                f32x16& re = x[pb]; f32x16& im = x[pb + 2];
                float myIr[4], myIi[4];
#pragma unroll
                for (int qq = 0; qq < 4; ++qq) {
#pragma unroll
                    for (int k = 1; k < 4; ++k) {
                        const float pr = re[4 * qq + k - 1], pi = im[4 * qq + k - 1];
                        re[4 * qq + k] += pr * ar[pb] - pi * ai[pb];
                        im[4 * qq + k] += pr * ai[pb] + pi * ar[pb];
                    }
                    const float er = re[4 * qq + 3], ei = im[4 * qq + 3];
                    const float per = __shfl_xor(er, 32), pei = __shfl_xor(ei, 32);
                    const float eAr = h ? per : er, eAi = h ? pei : ei, eBr = h ? er : per, eBi = h ? ei : pei;
                    const float IBr = Ir[pb] * a4r[pb] - Ii[pb] * a4i[pb] + eAr, IBi = Ir[pb] * a4i[pb] + Ii[pb] * a4r[pb] + eAi;
                    myIr[qq] = h ? IBr : Ir[pb]; myIi[qq] = h ? IBi : Ii[pb];
                    Ir[pb] = IBr * a4r[pb] - IBi * a4i[pb] + eBr; Ii[pb] = IBr * a4i[pb] + IBi * a4r[pb] + eBi;
                }
                if (PASS == 2) {
                    const float pwr[4] = {ar[pb], a2r[pb], a3r[pb], a4r[pb]}, pwi[4] = {ai[pb], a2i[pb], a3i[pb], a4i[pb]};
#pragma unroll
                    for (int i = 0; i < 16; ++i) {
                        const int qq = i >> 2, k = i & 3;
                        const float hr = re[i] + pwr[k] * myIr[qq] - pwi[k] * myIi[qq], hi_ = im[i] + pwr[k] * myIi[qq] + pwi[k] * myIr[qq];
                        *(LAS unsigned*)(himg + crow(i, h) * HI_LD + 4 * (32 * pb + r)) = pkbf(hr, hi_);
                    }
                }
            }
            if (PASS == 2) {
                asm volatile("s_waitcnt lgkmcnt(0)" ::: "memory");
#pragma unroll
                for (int tb = 0; tb < 2; ++tb) {
                    f32x4 d = {0.f, 0.f, 0.f, 0.f};
#pragma unroll
                    for (int s = 0; s < 4; ++s) {
                        const bf16x8 hb = *(const LAS bf16x8*)(himg + (16 * tb + fr) * HI_LD + (32 * s + 8 * fq) * 2);
                        d = MFMA16(cfrag[s], hb, d);
                    }
                    const size_t rowi = (size_t)(b * SEQ + t0 + 32 * mt + 16 * tb + fr);
                    const u32x2 uw = uwp[tb];
                    float yv[4] = {d[0] + dv[0] * bflo(uw.x), d[1] + dv[1] * bfhi(uw.x), d[2] + dv[2] * bflo(uw.y), d[3] + dv[3] * bfhi(uw.y)};
#pragma unroll
                    for (int e = 0; e < 4; ++e) { const float v = yv[e]; const float z = 1.5957691216057308f * (v + 0.044715f * v * v * v); yv[e] = v * rcpf(1.0f + ex2(-z * LOG2E)); }
                    u32x2 w; w.x = pkbf(yv[0], yv[1]); w.y = pkbf(yv[2], yv[3]);
                    *(u32x2*)(ybuf + rowi * 768 + g * 16 + 4 * fq) = w;
                }
                asm volatile("s_waitcnt lgkmcnt(0)" ::: "memory");
            }
        }
    }
    if (PASS == 1 && h == 0) {
        float* se = s5end + ((size_t)(b * 16 + rg) * 48 + g) * 128;
#pragma unroll
        for (int pb = 0; pb < 2; ++pb) { se[32 * pb + r] = Ir[pb]; se[64 + 32 * pb + r] = Ii[pb]; }
    }
}

#define XB_TMO      128
#define XB_XCNT(j)  (256  + 64 * (j))
#define XB_XSUB(j)  (1280 + 64 * (j))
#define XB_XGEN(j)  (2304 + 64 * (j))
#define XB_TOP      3328
#define XB_TOPGEN   3392
#define XCD_BAR_WORDS 3456
#define XB_SPIN_CAP (1u << 18)

__device__ __forceinline__ unsigned xb_ld(unsigned* p)              { return __hip_atomic_load(p, __ATOMIC_RELAXED, __HIP_MEMORY_SCOPE_AGENT); }
__device__ __forceinline__ unsigned xb_add(unsigned* p, unsigned v) { return __hip_atomic_fetch_add(p, v, __ATOMIC_RELAXED, __HIP_MEMORY_SCOPE_AGENT); }
__device__ __forceinline__ unsigned xb_xcc_id() { return (unsigned)__builtin_amdgcn_s_getreg((3 << 11) | 20) & 0xFu; }
#define XB_SPIN(cond, bar) do { unsigned _sp = 0; while (cond) { __builtin_amdgcn_s_sleep(1); \
    if ((++_sp & 255u) == 0u) { if (xb_ld(&(bar)[XB_TMO])) break; if (_sp > XB_SPIN_CAP) { atomicAdd(&(bar)[XB_TMO], 1u); break; } } } } while (0)

struct XcdBarrier {
    unsigned* bar; unsigned x;
    volatile LAS unsigned* st;
};

__device__ __forceinline__ XcdBarrier xcd_barrier_post(unsigned* bar, volatile LAS unsigned* st) {
    XcdBarrier b; b.bar = bar; b.x = xb_xcc_id(); b.st = st;
    if (threadIdx.x == 0) (void)xb_add(&bar[XB_XCNT(b.x)], 1u);
    return b;
}
__device__ __forceinline__ void xcd_barrier_complete(unsigned* bar, unsigned x, unsigned& nloc, unsigned& nx) {
    const unsigned G = gridDim.x * gridDim.y * gridDim.z;
    unsigned sum, cnt, mine, sp = 0u;
    for (;;) {
        sum = 0u; cnt = 0u; mine = 0u;
#pragma unroll
        for (unsigned j = 0; j < 16; ++j) { const unsigned c = xb_ld(&bar[XB_XCNT(j)]); sum += c; cnt += (c > 0u) ? 1u : 0u; mine = (j == x) ? c : mine; }
        if (sum == G) break;
        __builtin_amdgcn_s_sleep(1);
        if ((++sp & 255u) == 0u) { if (xb_ld(&bar[XB_TMO])) break; if (sp > XB_SPIN_CAP) { atomicAdd(&bar[XB_TMO], 1u); break; } }
    }
    nloc = mine > 0u ? mine : 1u; nx = cnt > 0u ? cnt : 1u;
}

__device__ __forceinline__ void xcd_barrier(const XcdBarrier& b) {
    asm volatile("s_waitcnt vmcnt(0)" ::: "memory");
    __syncthreads();
    if (threadIdx.x == 0) {
        unsigned* bar = b.bar;
        __builtin_amdgcn_s_waitcnt(0);
        unsigned nloc = b.st[0], nx = b.st[1];
        if (nloc == 0u) { xcd_barrier_complete(bar, b.x, nloc, nx); b.st[0] = nloc; b.st[1] = nx; }
        const unsigned old = xb_add(&bar[XB_XSUB(b.x)], 1u);
        const unsigned gen = old / nloc;
        if (old + 1u == (gen + 1u) * nloc) {
            __builtin_amdgcn_fence(__ATOMIC_RELEASE, "agent");
            asm volatile("s_waitcnt vmcnt(0)" ::: "memory");
            const unsigned og = xb_add(&bar[XB_TOP], 1u);
            const unsigned tg = og / nx;
            if (og + 1u == (tg + 1u) * nx) xb_add(&bar[XB_TOPGEN], 1u);
            else XB_SPIN(xb_ld(&bar[XB_TOPGEN]) == tg, bar);
            __builtin_amdgcn_fence(__ATOMIC_ACQUIRE, "agent");
            xb_add(&bar[XB_XGEN(b.x)], 1u);
            asm volatile("s_waitcnt vmcnt(0)" ::: "memory");
        } else {
            XB_SPIN(xb_ld(&bar[XB_XGEN(b.x)]) == gen, bar);
            __builtin_amdgcn_fence(__ATOMIC_ACQUIRE, "agent");
            asm volatile("s_waitcnt vmcnt(0)" ::: "memory");
        }
    }
    __syncthreads();
}

constexpr int N_PHASES = 38;
__host__ __device__ inline bool phase_empty(int ph) { if (ph == 0 || ph == 37) return false; const int l = (ph - 1) / 9, sub = (ph - 1) % 9; return ((sub == 4 || sub == 5) && l >= 2) || (sub == 3 && l < 2); }

#ifndef PROBE_DUP
#define PROBE_DUP 0
#endif
__device__ inline bool probe_dup(int ph) {
    if (PROBE_DUP == 0 || ph == 37) return false;
    if (ph == 0) return (PROBE_DUP & 2) != 0;
    const int sub = (ph - 1) % 9;
    return ((PROBE_DUP & 1) && (sub == 0 || sub == 7)) || ((PROBE_DUP & (4 | 64 | 128)) && sub == 3) || ((PROBE_DUP & 8) && sub == 4) || ((PROBE_DUP & 16) && sub == 2) || ((PROBE_DUP & 32) && sub == 5);
}
__global__ void __launch_bounds__(NTHREADS) mega(Params P) {
    extern __shared__ __attribute__((aligned(16))) unsigned char lds_raw[];
    LAS unsigned char* lds = (LAS unsigned char*)lds_raw;
    const int G = gridDim.x;
    if (P.ph_hi < 0) cg::this_grid().sync();
    const int wave_s = __builtin_amdgcn_readfirstlane((int)threadIdx.x >> 6);
    XcdBarrier bar; bar.bar = (unsigned*)(P.ws + WS_BAR); bar.x = 0; bar.st = nullptr;
    if (P.ph_hi - P.ph_lo > 1) {
        LAS unsigned* misc = (LAS unsigned*)(lds + LDS_MISC);
        if (threadIdx.x < 16) misc[threadIdx.x] = 0u;
        __syncthreads();
        bar = xcd_barrier_post((unsigned*)(P.ws + WS_BAR), (volatile LAS unsigned*)(misc + 8));
    }
    bool dup_done = false;
    for (int ph = P.ph_lo; ph < P.ph_hi; ) {
        if (phase_empty(ph)) { ++ph; continue; }
        int lane_ = (int)__builtin_amdgcn_mbcnt_hi(~0u, __builtin_amdgcn_mbcnt_lo(~0u, 0u)); asm volatile("" : "+v"(lane_));
        const int tid = (wave_s << 6) | lane_;
        int bid = blockIdx.x; asm volatile("" : "+s"(bid));
        const int lane = lane_, wave = wave_s;
    unsigned char* ws = P.ws;
    bf16_t* xb = (bf16_t*)(ws + WS_XB); float* part = (float*)(ws + WS_PART); const float* rope = (const float*)(ws + WS_ROPE);
    bf16_t* act = (bf16_t*)(ws + WS_ACT); bf16_t* proj = (bf16_t*)(ws + WS_PROJ); bf16_t* mixcat = (bf16_t*)(ws + WS_MIXCAT); bf16_t* ybuf = (bf16_t*)(ws + WS_YBUF);
    bf16_t* kbuf = (bf16_t*)(ws + WS_KBUF); bf16_t* vtb = (bf16_t*)(ws + WS_VT); bf16_t* mkv = (bf16_t*)(ws + WS_MKV);

        if (ph == 0) {
#ifndef SKIP_PREP
            prep_phase(P, lds, tid, bid);
#endif
        } else if (ph == 37) {
            const float* g = P.in[30]; float* out = P.out;
            for (int row = bid * NWAVES + wave; row < T; row += G * NWAVES) {
                const float pv = (lane < 16) ? part[(size_t)row * 16 + lane] : 0.f;
                const float rs = rsqrtf(wave_sum(pv) * (1.0f / 1024.0f) + EPS);
#pragma unroll
                for (int jj = 0; jj < 4; ++jj) {
                    float* p = out + (size_t)row * DM + 4 * lane + 256 * jj;
                    const f32x4 v = *(const f32x4*)p; const f32x4 gg = *(const f32x4*)(g + 4 * lane + 256 * jj);
                    *(f32x4*)p = v * rs * gg;
                }
            }
        } else {
            const int l = (ph - 1) / 9, sub = (ph - 1) % 9;
            if (sub == 0 || sub == 7) {
                const bf16_t* W = (const bf16_t*)(sub == 0 ? ws + WS_F1IN + l * SZ_F1IN : ws + WS_F2IN + l * SZ_F2IN);
                const int N = (sub == 0 && l == 2) ? 7168 : 5632;
                pg8::Gemm g{xb, W, T, N, 1024}; pg8::StaticOrder S; S.init(T, N, G, bid);
                EpiSwiglu E{act, part, kbuf, vtb, rope};
#ifndef SKIP_FIN
                pg8::gemm_phase<EpiSwiglu, pg8::StaticOrder, true, true>(lds, g, S, E, tid);
#endif
                if (ph == 1) {
                    pg8::Gemm g2{(const bf16_t*)(ws + WS_MEMNB), (const bf16_t*)(ws + WS_MEMKVW), 1024, 2048, 1024}; pg8::StaticOrder S2; S2.init(1024, 2048, G, bid >= G / 2 ? bid - G / 2 : 1 << 20);
                    EpiPlain E2{mkv, 2048};
#ifndef SKIP_PLAIN
                    pg8::gemm_phase<EpiPlain, pg8::StaticOrder, true, true>(lds, g2, S2, E2, tid);
#endif
                }
                {
                    const int tk = (ph == 1) ? 0 : (ph == 8) ? 1 : (ph == 10) ? 2 : (ph == 17) ? 3 : (ph == 26) ? 4 : (ph == 28) ? 5 : -1;
                    if (tk >= 0 && bid >= G / 2 && !dup_done) {
                        LAS float* scr = (LAS float*)(lds + wave * 8448);
                        const int nw = (G - G / 2) * NWAVES, w0 = (bid - G / 2) * NWAVES + wave;
                        const int dend = (tk + 1) * 4864 < 28416 ? (tk + 1) * 4864 : 28416;
#pragma unroll 1
                        for (int d = tk * 4864 + w0; d < dend; d += nw) { const int lq = d / 9472; convert_item(P, ws, (lq + 1) * 9728 + (d - lq * 9472), scr, lane); }
                    }
                }
            } else if (sub == 1 || sub == 6 || sub == 8) {
                const bf16_t* A = (sub == 6) ? mixcat : act;
                const int K = (sub == 6) ? 1024 : DFF;
                const bf16_t* W = (const bf16_t*)(sub == 1 ? ws + WS_F1OUT + l * SZ_FOUT : sub == 8 ? ws + WS_F2OUT + l * SZ_FOUT : ws + WS_MIXOUT + l * SZ_SQ);
                pg8::Gemm g{A, W, T, 1024, K}; pg8::StaticOrder S; S.init(T, 1024, G, bid);
                EpiResid E{ph == 36 ? P.out : (float*)nullptr, xb, part, sub == 6 ? 1.0f : 0.5f};
#ifndef SKIP_RESID
                pg8::gemm_phase<EpiResid, pg8::StaticOrder, true, true>(lds, g, S, E, tid);
#endif
            } else if (sub == 2) {
                pg8::Gemm g{xb, (const bf16_t*)(ws + WS_MIXIN + l * SZ_SQ), T, 1024, 1024}; pg8::StaticOrder S; S.init(T, 1024, G, bid);
                EpiProj E{proj, part, rope, l >= 2 ? 1 : 0};
#ifndef SKIP_PROJ
                pg8::gemm_phase<EpiProj, pg8::StaticOrder, true, true>(lds, g, S, E, tid);
#endif
                if (l < 2 && !dup_done) {
                    asm volatile("s_waitcnt vmcnt(0)" ::: "memory");
                    __syncthreads();
                    pg8::Unit u0;
                    for (int i = 0; S.next(i, u0); ++i) {
                        if (u0.pn < 3) {
#pragma unroll 1
                            for (int k = 0; k < 2; ++k) {
                                const int g_ = 16 * u0.pn + wave + 8 * k, t_ = ((((u0.pm >> 4) * 48 + g_) << 4) | (u0.pm & 15));
                                s5_task<1>(proj, (const float*)(ws + WS_S5A), (const float*)(ws + WS_S5AL), (const bf16_t*)(ws + WS_S5B), (const bf16_t*)(ws + WS_S5C), P.in[21], (float*)(ws + WS_S5END), ybuf, l, t_, lds + wave * 8704, lane);
                            }
                        }
                    }
                }
            } else if (sub == 3) {
#ifndef SKIP_MEM
#endif
                if (dup_done && (PROBE_DUP & 128)) {} else if (l < 2) {
                } else {
                    const float* cf = (const float*)(ws + WS_CTL); const float lam = cf[16 + 2 * (l - 2)], oml = cf[17 + 2 * (l - 2)];
                    unsigned* ctr = (unsigned*)(ws + WS_CTL) + 64 + ((l - 2) * 2 + (dup_done ? 1 : 0)) * 8;
                    LAS unsigned* tk = (LAS unsigned*)(lds + LDS_MISC + 16);
                    const bool firstA = bid < (G * 3) / 4;
#pragma unroll 1
                    for (int pass_ = 0; pass_ < 2; ++pass_) {
                        const int q_ = ((pass_ == 0) == firstA) ? 0 : 1;
                        unsigned* cq = ctr + q_;
                        for (;;) {
                            if (tid == 0) tk[0] = atomicAdd(cq, 1u);
                            __syncthreads();
                            const unsigned t = tk[0];
                            __syncthreads();
                            if (t >= 384u) break;
                            diff_attn_task(proj, kbuf, vtb, mixcat, P.in[29] + (l - 2) * 128, lam, oml, (int)t + (q_ ? 384 : 0), lds, tid);
                        }
                    }
                    for (;;) {
                        if (tid == 0) tk[0] = atomicAdd(ctr + 2, 1u);
                        __syncthreads();
                        const unsigned t = tk[0];
                        __syncthreads();
                        if (t >= 256u) break;
                        mem_attn_task(proj, mkv + l * 512, mixcat, (int)t, lds, tid);
                    }
                }
            } else if (sub == 4) {
                if (!dup_done) for (int t = bid; t < 256; t += G) mem_attn_task(proj, mkv + l * 512, mixcat, t, lds, tid);
                for (int t = bid * NWAVES + wave; t < 3072; t += G * NWAVES)
#ifndef SKIP_S52
                    s5_task<2>(proj, (const float*)(ws + WS_S5A), (const float*)(ws + WS_S5AL), (const bf16_t*)(ws + WS_S5B), (const bf16_t*)(ws + WS_S5C), P.in[21], (float*)(ws + WS_S5END), ybuf, l, t, lds + wave * 8704, lane);
#endif
                    ;
            } else if (sub == 5) {
                pg8::Gemm g{ybuf, (const bf16_t*)(ws + WS_GLU + l * SZ_GLU), T, 768, 768}; pg8::StaticOrder S; S.init(T, 768, G, bid);
                EpiGlu E{ybuf, mixcat};
#ifndef SKIP_GLU
                pg8::gemm_phase<EpiGlu, pg8::StaticOrder, true, true>(lds, g, S, E, tid);
#endif
            }
        }
        if (ph + 1 < P.ph_hi) xcd_barrier(bar);
        if (probe_dup(ph) && !dup_done) dup_done = true; else { dup_done = false; ++ph; }
    }
}

extern "C" void kernel_launch(void* const* d_in, const int* in_sizes, int n_in, void* d_out, int out_size, void* d_ws, size_t ws_size, hipStream_t stream) {
    static int grid = 0;
    if (grid == 0) {
        if (n_in != 31 || ws_size < WS_END) { fprintf(stderr, "kernel_launch: need 31 inputs and %zu bytes of workspace (got %d, %zu)\n", (size_t)WS_END, n_in, ws_size); grid = -1; return; }
        int dev = 0, cus = 0, per_cu = 0;
        (void)hipGetDevice(&dev); (void)hipDeviceGetAttribute(&cus, hipDeviceAttributeMultiprocessorCount, dev);
        if (hipFuncSetAttribute((const void*)mega, hipFuncAttributeMaxDynamicSharedMemorySize, LDS_BYTES) != hipSuccess) { fprintf(stderr, "kernel_launch: hipFuncSetAttribute failed\n"); grid = -1; return; }
        if (hipOccupancyMaxActiveBlocksPerMultiprocessor(&per_cu, (const void*)mega, NTHREADS, LDS_BYTES) != hipSuccess || per_cu < 1) { fprintf(stderr, "kernel_launch: occupancy query says %d\n", per_cu); per_cu = 1; }
        (void)hipGetLastError();
        grid = cus * 1;
    }
    if (grid < 0) return;
    if (hipMemsetAsync(d_ws, 0, WS_ZERO_BYTES, stream) != hipSuccess) { fprintf(stderr, "kernel_launch: memset of the control words failed\n"); return; }
    Params p{};
    for (int i = 0; i < 31; ++i) p.in[i] = (const float*)d_in[i];
    p.out = (float*)d_out; p.ws = (unsigned char*)d_ws;
#if MK_MULTI
    for (int ph = 0; ph < N_PHASES; ++ph) {
        if (phase_empty(ph)) continue;
        p.ph_lo = ph; p.ph_hi = ph + 1;
        hipLaunchKernelGGL(mega, dim3(grid), dim3(NTHREADS), LDS_BYTES, stream, p);
    }
#else
    p.ph_lo = 0; p.ph_hi = N_PHASES;
    void* args[] = {&p};
    hipError_t e = hipLaunchCooperativeKernel((const void*)mega, dim3(grid), dim3(NTHREADS), args, LDS_BYTES, stream);
    if (e != hipSuccess) fprintf(stderr, "kernel_launch: cooperative launch failed: %s (grid %d)\n", hipGetErrorString(e), grid);
#endif
}
```

```cpp
#include <hip/hip_runtime.h>
#include <hip/hip_cooperative_groups.h>
#include <cstdio>
#include <cstdint>
namespace cg = cooperative_groups;
#ifndef MK_MULTI
#define MK_MULTI 0
#endif
#define PROBE_DUP 0
namespace pg8 {
#define PG8_LAS __attribute__((address_space(3)))
typedef unsigned short bf16_t;
typedef short bf16x8 __attribute__((ext_vector_type(8)));
typedef float f32x4 __attribute__((ext_vector_type(4)));
typedef unsigned u32x4 __attribute__((ext_vector_type(4)));
constexpr int BM = 256, BK = 64, HALF = 128, HTB = HALF * BK * 2  , STAGE_BYTES = 8 * HTB, NXCD = 8, WGM = 8;

__host__ __device__ __forceinline__ int lds_byte(int r, int c) { const int st = (r >> 4) * 2 + (c >> 5), rr = r & 15, cc = c & 31, ob = rr * 64 + cc * 2; return st * 1024 + (ob ^ (((ob >> 9) & 1) << 5)); }
__host__ __device__ __forceinline__ void stage_rc(int b, int& R, int& C) { const int st = b / 1024, sb = b % 1024, swz = sb ^ (((sb >> 9) & 1) << 5); R = (st >> 1) * 16 + swz / 64; C = (st & 1) * 32 + (swz % 64) / 2; }
__host__ __device__ __forceinline__ int perm32(int rho) { const int n = rho >> 4, i = rho & 15; return 8 * (i >> 2) + 4 * n + (i & 3); }

struct Unit { int pm, pn; };
struct Gemm { const bf16_t* A; const bf16_t* Bt; int M, N, K; };

struct StaticOrder {
    int nM, nN, nwg, G, c;
    __host__ __device__ void init(int M, int N, int G_, int c_) { nM = M / BM; nN = N / BM; nwg = nM * nN; G = G_; c = c_; }
    __host__ __device__ bool next(int i, Unit& u) const {
        const long L = (long)i * G + c; if (L >= nwg) return false;
        int wgid = (int)L; { const int q = nwg / NXCD, r = nwg % NXCD, xcd = wgid % NXCD, off = wgid / NXCD; wgid = (xcd < r ? xcd * (q + 1) : r * (q + 1) + (xcd - r) * q) + off; }
        const int nig = WGM * nN, gid = wgid / nig, fm = gid * WGM, gsz = (nM - fm) < WGM ? (nM - fm) : WGM;
        u.pm = fm + ((wgid % nig) % gsz); u.pn = (wgid % nig) / gsz; return true;
    }
    __device__ __forceinline__ void a_ready(const Unit&) const {}
    __device__ __forceinline__ void done(const Unit&) const {}
};

__device__ __forceinline__ unsigned cvt_pk_bf16(float lo, float hi) { unsigned r; asm volatile("v_cvt_pk_bf16_f32 %0, %1, %2" : "=v"(r) : "v"(lo), "v"(hi)); return r; }
template <class Epi, class Sched, bool ALIGN_EPI = false, bool SP2 = false>
__device__ __forceinline__ void gemm_phase(PG8_LAS unsigned char* lds, const Gemm g, const Sched& S, const Epi& E, const int tid_in) {
    const int tid = tid_in, wid = __builtin_amdgcn_readfirstlane(tid >> 6), lane = tid & 63, wr = wid >> 2, wc = wid & 3, fr = lane & 15, fq = lane >> 4;
    const int K = g.K, nt = K / BK;
    unsigned voffA[2], voffB[2];
#pragma unroll
    for (int i = 0; i < 2; ++i) { int R, C; stage_rc(tid * 16 + i * 8192, R, C); const int Rb = Epi::PERM ? ((R & ~31) + perm32(R & 31)) : R;
        voffA[i] = (unsigned)(R * K + C) * 2u; voffB[i] = (unsigned)(Rb * K + C) * 2u; }
    const size_t kstep = (size_t)(BK * 2);
    const size_t hstep = (size_t)HALF * K * 2;
    const size_t tstep = 2 * hstep;
    const unsigned ldsw = (unsigned)wid * 1024u;
    const int aoff = lds_byte(wr * 64 + fr, fq * 8), boff = lds_byte(wc * 32 + fr, fq * 8);
#define PG8_SA(b, h) (((b) * 2 + (h)) * HTB)
#define PG8_SB(b, h) ((4 + (b) * 2 + (h)) * HTB)
#define PG8_STAGE(bufoff, gbase, voff) do { _Pragma("unroll") for (int _i = 0; _i < 2; ++_i) \
        __builtin_amdgcn_global_load_lds((const unsigned*)((const char*)(gbase) + (voff)[_i]), (PG8_LAS unsigned*)(lds + (bufoff) + ldsw + _i * 8192), 16, 0, 0); } while (0)
#define PG8_LDA(dst, b, h) do { _Pragma("unroll") for (int m = 0; m < 4; ++m) _Pragma("unroll") for (int k = 0; k < 2; ++k) dst[m][k] = *(const PG8_LAS bf16x8*)(lds + PG8_SA(b, h) + aoff + m * 2048 + k * 1024); } while (0)
#define PG8_LDB(dst, b, h) do { _Pragma("unroll") for (int n = 0; n < 2; ++n) _Pragma("unroll") for (int k = 0; k < 2; ++k) dst[n][k] = *(const PG8_LAS bf16x8*)(lds + PG8_SB(b, h) + boff + n * 2048 + k * 1024); } while (0)
#define PG8_MMA(ai, bj, At, Bt) do { __builtin_amdgcn_s_setprio(1); _Pragma("unroll") for (int m = 0; m < 4; ++m) _Pragma("unroll") for (int n = 0; n < 2; ++n) _Pragma("unroll") for (int k = 0; k < 2; ++k) \
        acc[ai][bj][m][n] = __builtin_amdgcn_mfma_f32_16x16x32_bf16(Bt[n][k], At[m][k], acc[ai][bj][m][n], 0, 0, 0); __builtin_amdgcn_s_setprio(0); } while (0)
#define PG8_WAIT_V(n) asm volatile("s_waitcnt vmcnt(" #n ")" ::: "memory")
#define PG8_WAIT_L(n) asm volatile("s_waitcnt lgkmcnt(" #n ")" ::: "memory")
#define PG8_BAR __builtin_amdgcn_s_barrier()
#define PG8_SCHED __builtin_amdgcn_sched_barrier(0)
    Unit cur, nxt; int ui = 0;
    if (!S.next(0, cur)) return;
    f32x4 acc[2][2][4][2];
#pragma unroll
    for (int a = 0; a < 2; ++a)
#pragma unroll
        for (int b = 0; b < 2; ++b)
#pragma unroll
            for (int m = 0; m < 4; ++m)
#pragma unroll
                for (int n = 0; n < 2; ++n) acc[a][b][m][n] = (f32x4){0.f, 0.f, 0.f, 0.f};
    bf16x8 At[4][2], B0[2][2], B1[2][2];
    const char* cA = (const char*)g.A + (size_t)cur.pm * tstep; const char* cB = (const char*)g.Bt + (size_t)cur.pn * tstep;
    S.a_ready(cur);
    if constexpr (SP2) {
        PG8_STAGE(PG8_SB(0, 0), cB, voffB); PG8_STAGE(PG8_SB(0, 1), cB + hstep, voffB); PG8_STAGE(PG8_SA(0, 0), cA, voffA); PG8_STAGE(PG8_SA(0, 1), cA + hstep, voffA);
        if (wr == 1) PG8_BAR;
        PG8_WAIT_V(2); PG8_BAR;
        PG8_STAGE(PG8_SB(1, 0), cB + kstep, voffB); PG8_STAGE(PG8_SA(1, 0), cA + kstep, voffA); PG8_STAGE(PG8_SB(1, 1), cB + hstep + kstep, voffB);
        PG8_WAIT_V(6); PG8_BAR;
    } else {
        PG8_STAGE(PG8_SB(0, 0), cB, voffB); PG8_STAGE(PG8_SA(0, 0), cA, voffA); PG8_STAGE(PG8_SB(0, 1), cB + hstep, voffB); PG8_STAGE(PG8_SA(0, 1), cA + hstep, voffA);
        if (wr == 1) PG8_BAR;
        PG8_WAIT_V(4); PG8_BAR;
        PG8_STAGE(PG8_SB(1, 0), cB + kstep, voffB); PG8_STAGE(PG8_SA(1, 0), cA + kstep, voffA); PG8_STAGE(PG8_SB(1, 1), cB + hstep + kstep, voffB);
        PG8_WAIT_V(6); PG8_BAR;
    }
    for (;;) {
        const bool has_next = S.next(ui + 1, nxt);
        const char* nA = has_next ? (const char*)g.A + (size_t)nxt.pm * tstep : cA; const char* nB = has_next ? (const char*)g.Bt + (size_t)nxt.pn * tstep : cB;
        for (int t = 0; t < nt; t += 2) {
            const bool last = (t == nt - 2);
            const char* a1 = cA + (size_t)(t + 1) * kstep;
            const char* a2 = last ? nA : cA + (size_t)(t + 2) * kstep; const char* b2 = last ? nB : cB + (size_t)(t + 2) * kstep;
            const char* a3 = a2 + kstep; const char* b3 = b2 + kstep;
            if (last && has_next) S.a_ready(nxt);
            if constexpr (SP2) {
            PG8_LDB(B0, 0, 0); PG8_LDB(B1, 0, 1); PG8_SCHED; PG8_LDA(At, 0, 0); PG8_STAGE(PG8_SA(1, 1), a1 + hstep, voffA);
            PG8_WAIT_V(8); PG8_WAIT_L(0); PG8_BAR; PG8_MMA(0, 0, At, B0); PG8_MMA(0, 1, At, B1); PG8_BAR; PG8_SCHED;
            PG8_LDA(At, 0, 1); PG8_STAGE(PG8_SB(0, 0), b2, voffB); PG8_STAGE(PG8_SB(0, 1), b2 + hstep, voffB); PG8_STAGE(PG8_SA(0, 0), a2, voffA);
            PG8_WAIT_V(8); PG8_WAIT_L(0); PG8_BAR; PG8_MMA(1, 0, At, B0); PG8_MMA(1, 1, At, B1); PG8_BAR; PG8_SCHED;
            PG8_LDB(B0, 1, 0); PG8_LDB(B1, 1, 1); PG8_SCHED; PG8_LDA(At, 1, 0); PG8_STAGE(PG8_SA(0, 1), a2 + hstep, voffA);
            PG8_WAIT_V(8); PG8_WAIT_L(0); PG8_BAR; PG8_MMA(0, 0, At, B0); PG8_MMA(0, 1, At, B1); PG8_BAR; PG8_SCHED;
            PG8_LDA(At, 1, 1); PG8_STAGE(PG8_SB(1, 0), b3, voffB); PG8_STAGE(PG8_SB(1, 1), b3 + hstep, voffB); PG8_STAGE(PG8_SA(1, 0), a3, voffA);
            PG8_WAIT_V(8); PG8_WAIT_L(0); PG8_BAR; PG8_MMA(1, 0, At, B0); PG8_MMA(1, 1, At, B1); PG8_BAR; PG8_SCHED;
            } else {
            PG8_LDB(B0, 0, 0); PG8_SCHED; PG8_LDA(At, 0, 0); PG8_STAGE(PG8_SA(1, 1), a1 + hstep, voffA);
            PG8_WAIT_L(8); PG8_BAR; PG8_WAIT_L(0); PG8_MMA(0, 0, At, B0); PG8_BAR; PG8_SCHED;
            PG8_LDB(B1, 0, 1); PG8_STAGE(PG8_SB(0, 0), b2, voffB);
            PG8_BAR; PG8_WAIT_L(0); PG8_MMA(0, 1, At, B1); PG8_BAR;
            PG8_LDA(At, 0, 1); PG8_STAGE(PG8_SA(0, 0), a2, voffA);
            PG8_BAR; PG8_WAIT_L(0); PG8_MMA(1, 0, At, B0); PG8_BAR; PG8_SCHED;
            PG8_STAGE(PG8_SB(0, 1), b2 + hstep, voffB);
            PG8_WAIT_V(6); PG8_BAR; PG8_MMA(1, 1, At, B1); PG8_BAR;
            PG8_LDB(B0, 1, 0); PG8_SCHED; PG8_LDA(At, 1, 0); PG8_STAGE(PG8_SA(0, 1), a2 + hstep, voffA);
            PG8_WAIT_L(8); PG8_BAR; PG8_WAIT_L(0); PG8_MMA(0, 0, At, B0); PG8_BAR; PG8_SCHED;
            PG8_LDB(B1, 1, 1); PG8_STAGE(PG8_SB(1, 0), b3, voffB);
            PG8_BAR; PG8_WAIT_L(0); PG8_MMA(0, 1, At, B1); PG8_BAR;
            PG8_LDA(At, 1, 1); PG8_STAGE(PG8_SA(1, 0), a3, voffA);
            PG8_BAR; PG8_WAIT_L(0); PG8_MMA(1, 0, At, B0); PG8_BAR; PG8_SCHED;
            PG8_STAGE(PG8_SB(1, 1), b3 + hstep, voffB);
            PG8_WAIT_V(6); PG8_BAR; PG8_MMA(1, 1, At, B1); PG8_BAR;
            }
        }
        if constexpr (ALIGN_EPI) { if (wr == 0) PG8_BAR; }
        if constexpr (!Epi::AFTER_DRAIN) { E(acc, cur, wr, wc, fr, fq); S.done(cur); }
        if (!has_next) break;
#pragma unroll
        for (int a = 0; a < 2; ++a)
#pragma unroll
            for (int b = 0; b < 2; ++b)
#pragma unroll
                for (int m = 0; m < 4; ++m)
#pragma unroll
                    for (int n = 0; n < 2; ++n) acc[a][b][m][n] = (f32x4){0.f, 0.f, 0.f, 0.f};
        cur = nxt; cA = nA; cB = nB; ++ui;
        if constexpr (ALIGN_EPI) { if (wr == 1) PG8_BAR; }
    }
    PG8_WAIT_V(0);
    if constexpr (!ALIGN_EPI) { if (wr == 0) PG8_BAR; }
    PG8_BAR;
    if constexpr (Epi::AFTER_DRAIN) { E.fused(acc, cur, wr, wc, fr, fq, lds, wid, lane); S.done(cur); }
#undef PG8_SA
#undef PG8_SB
#undef PG8_STAGE
#undef PG8_LDA
#undef PG8_LDB
#undef PG8_MMA
#undef PG8_WAIT_V
#undef PG8_WAIT_L
#undef PG8_BAR
#undef PG8_SCHED
}
}

#define LAS __attribute__((address_space(3)))
#define DI __device__ __forceinline__
typedef unsigned short bf16_t;
typedef short bf16x8 __attribute__((ext_vector_type(8)));
typedef short s16x4 __attribute__((ext_vector_type(4)));
typedef float f32x4 __attribute__((ext_vector_type(4)));
typedef float f32x16 __attribute__((ext_vector_type(16)));
typedef unsigned u32x4 __attribute__((ext_vector_type(4)));
typedef unsigned u32x2 __attribute__((ext_vector_type(2)));
typedef float f32x2_t __attribute__((ext_vector_type(2)));
typedef __bf16 bf16x2_t __attribute__((ext_vector_type(2)));

constexpr int T = 16384, DM = 1024, DFF = 2816, SEQ = 4096, NB = 4;
constexpr float C2 = 0.125f * 1.4426950408889634f;
constexpr float LOG2E = 1.4426950408889634f;
constexpr float EPS = 1e-6f;
constexpr int NTHREADS = 512, NWAVES = 8;
constexpr int LDS_BYTES = 131072 + 256;
constexpr int LDS_MISC = 131072;

constexpr size_t al256(size_t x) { return (x + 255) & ~(size_t)255; }
constexpr size_t SZ_F1IN = (size_t)7168 * 1024 * 2, SZ_F2IN = (size_t)5632 * 1024 * 2, SZ_FOUT = (size_t)1024 * 2816 * 2, SZ_SQ = (size_t)1024 * 1024 * 2, SZ_GLU = (size_t)768 * 768 * 2;
constexpr size_t WS_CTL = 0;
constexpr size_t WS_BAR = 4096;
constexpr size_t WS_ZERO_BYTES = 4096 + 16384;
constexpr size_t WS_F1IN = WS_ZERO_BYTES;
constexpr size_t WS_F2IN = WS_F1IN + 4 * SZ_F1IN;
constexpr size_t WS_F1OUT = WS_F2IN + 4 * SZ_F2IN;
constexpr size_t WS_F2OUT = WS_F1OUT + 4 * SZ_FOUT;
constexpr size_t WS_MIXIN = WS_F2OUT + 4 * SZ_FOUT;
constexpr size_t WS_MIXOUT = WS_MIXIN + 4 * SZ_SQ;
constexpr size_t WS_GLU = WS_MIXOUT + 4 * SZ_SQ;
constexpr size_t WS_MEMKVW = WS_GLU + 2 * SZ_GLU;
constexpr size_t WS_XB = WS_MEMKVW + (size_t)2048 * 1024 * 2;
constexpr size_t WS_PART = WS_XB + (size_t)T * 1024 * 2;
constexpr size_t WS_ROPE = WS_PART + (size_t)T * 16 * 4;
constexpr size_t WS_MEMNB = WS_ROPE + (size_t)T * 16 * 4;
constexpr size_t WS_MKV = WS_MEMNB + (size_t)1024 * 1024 * 2;
constexpr size_t WS_KBUF = WS_MKV + (size_t)1024 * 2048 * 2;
constexpr size_t WS_VT = WS_KBUF + (size_t)T * 768 * 2;
constexpr size_t WS_S5A = WS_VT + (size_t)T * 768 * 2;
constexpr size_t WS_S5AL = WS_S5A + 2 * 48 * 128 * 4;
constexpr size_t WS_S5B = WS_S5AL + 2 * 48 * 128 * 4;
constexpr size_t WS_S5C = WS_S5B + 2 * 48 * 128 * 16 * 2;
constexpr size_t WS_S5END = WS_S5C + 2 * 48 * 16 * 128 * 2;
constexpr size_t WS_ACT = al256(WS_S5END + (size_t)4 * 64 * 48 * 128 * 4);
constexpr size_t WS_PROJ = WS_ACT;
constexpr size_t WS_MIXCAT = WS_ACT + (size_t)T * 1024 * 2;
constexpr size_t WS_YBUF = WS_MIXCAT + (size_t)T * 1024 * 2;
constexpr size_t WS_END = WS_ACT + (size_t)T * 2816 * 2;
static_assert(WS_YBUF + (size_t)T * 768 * 2 <= WS_END, "overlay");

struct Params { const float* in[31]; float* out; unsigned char* ws; int ph_lo, ph_hi; };

DI unsigned pkbf(float lo, float hi) { f32x2_t v = {lo, hi}; bf16x2_t b = __builtin_convertvector(v, bf16x2_t); return __builtin_bit_cast(unsigned, b); }
DI float bflo(unsigned w) { return __uint_as_float(w << 16); }
DI float bfhi(unsigned w) { return __uint_as_float(w & 0xffff0000u); }
DI float wave_sum(float v) {
#pragma unroll
    for (int o = 1; o < 64; o <<= 1) v += __shfl_xor(v, o);
    return v;
}
DI float ex2(float x) { return __builtin_amdgcn_exp2f(x); }
DI float rcpf(float x) { return __builtin_amdgcn_rcpf(x); }
DI float xor32_max(float v) { const auto r_ = __builtin_amdgcn_permlane32_swap(__float_as_uint(v), __float_as_uint(v), false, false); return fmaxf(__uint_as_float(r_[0]), __uint_as_float(r_[1])); }
DI float xor32_sum(float v) { const auto r_ = __builtin_amdgcn_permlane32_swap(__float_as_uint(v), __float_as_uint(v), false, false); return __uint_as_float(r_[0]) + __uint_as_float(r_[1]); }
DI int crow(int i, int h) { return (i & 3) + 8 * (i >> 2) + 4 * h; }
#define MFMA32(a, b, c) __builtin_amdgcn_mfma_f32_32x32x16_bf16((a), (b), (c), 0, 0, 0)
#define MFMA16(a, b, c) __builtin_amdgcn_mfma_f32_16x16x32_bf16((a), (b), (c), 0, 0, 0)

DI float row_rstd(const float* part, int row, int fq) {
    const f32x4 p = *(const f32x4*)(part + (size_t)row * 16 + 4 * fq);
    float s = (p[0] + p[1]) + (p[2] + p[3]);
    s += __shfl_xor(s, 16); s += __shfl_xor(s, 32);
    return rsqrtf(s * (1.0f / 1024.0f) + EPS);
}
DI u32x4 pack8(const f32x4 a, const f32x4 b) { u32x4 w; w.x = pkbf(a[0], a[1]); w.y = pkbf(a[2], a[3]); w.z = pkbf(b[0], b[1]); w.w = pkbf(b[2], b[3]); return w; }

DI void rope8(f32x4& v0, f32x4& v1, const float* rope, int row, int fq) {
    const f32x4 c0 = *(const f32x4*)(rope + (size_t)row * 16), c1 = *(const f32x4*)(rope + (size_t)row * 16 + 4);
    const f32x4 s0 = *(const f32x4*)(rope + (size_t)row * 16 + 8), s1 = *(const f32x4*)(rope + (size_t)row * 16 + 12);
    f32x4 p0, p1;
#pragma unroll
    for (int e = 0; e < 4; ++e) { p0[e] = __shfl_xor(v0[e], 16); p1[e] = __shfl_xor(v1[e], 16); }
    if (fq < 2) {
        const float sg = (fq == 0) ? -1.f : 1.f;
        v0 = v0 * c0 + sg * (p0 * s0); v1 = v1 * c1 + sg * (p1 * s1);
    }
}

struct EpiSwiglu {
    static constexpr bool PERM = true, AFTER_DRAIN = false;
    bf16_t* act; const float* part; bf16_t* kout; bf16_t* vtout; const float* rope;
    DI void operator()(const f32x4 (&acc)[2][2][4][2], const pg8::Unit& u, int wr, int wc, int fr, int fq) const {
        const int row0 = u.pm * 256 + wr * 64 + fr;
        if (u.pn < 22) {
            const int col = u.pn * 128 + wc * 32 + 8 * fq;
#pragma unroll
            for (int ai = 0; ai < 2; ++ai)
#pragma unroll
                for (int m = 0; m < 4; ++m) {
                    const int row = row0 + ai * 128 + m * 16; const float rs = row_rstd(part, row, fq);
                    f32x4 o[2];
#pragma unroll
                    for (int n = 0; n < 2; ++n) {
                        const f32x4 g = acc[ai][0][m][n] * rs, up = acc[ai][1][m][n] * rs;
#pragma unroll
                        for (int e = 0; e < 4; ++e) o[n][e] = g[e] * up[e] * rcpf(1.0f + ex2(-g[e] * LOG2E));
                    }
                    *(u32x4*)(act + (size_t)row * DFF + col) = pack8(o[0], o[1]);
                }
        } else {
            const int t = u.pn - 22;
#pragma unroll
            for (int ai = 0; ai < 2; ++ai)
#pragma unroll
                for (int m = 0; m < 4; ++m) {
                    const int row = row0 + ai * 128 + m * 16; const float rs = row_rstd(part, row, fq);
#pragma unroll
                    for (int bj = 0; bj < 2; ++bj) {
                        f32x4 v0 = acc[ai][bj][m][0] * rs, v1 = acc[ai][bj][m][1] * rs;
                        if (t < 3) {
                            if ((wc & 1) == 0) rope8(v0, v1, rope, row, fq);
                            *(u32x4*)(kout + (size_t)row * 768 + t * 256 + bj * 128 + wc * 32 + 8 * fq) = pack8(v0, v1);
                        } else {
                            const int hd = (t - 3) * 2 + bj, dv0 = wc * 32 + 8 * fq, b = row >> 12, s = row & 4095;
                            bf16_t* vp = vtout + ((size_t)(b * 6 + hd) * 128 + dv0) * 4096 + s;
                            const u32x4 w = pack8(v0, v1);
#pragma unroll
                            for (int e = 0; e < 4; ++e) { vp[(size_t)(2 * e) * 4096] = (bf16_t)(w[e] & 0xffffu); vp[(size_t)(2 * e + 1) * 4096] = (bf16_t)(w[e] >> 16); }
                        }
                    }
                }
        }
    }
};
struct EpiResid {
    static constexpr bool PERM = true, AFTER_DRAIN = false;
    float* xf; bf16_t* xb; float* part; float alpha;
    DI void operator()(const f32x4 (&acc)[2][2][4][2], const pg8::Unit& u, int wr, int wc, int fr, int fq) const {
        const int row0 = u.pm * 256 + wr * 64 + fr, col = u.pn * 256 + wc * 32 + 8 * fq;
#pragma unroll
        for (int ai = 0; ai < 2; ++ai) {
            u32x4 pre[4][2];
#pragma unroll
            for (int m = 0; m < 4; ++m)
#pragma unroll
                for (int bj = 0; bj < 2; ++bj) pre[m][bj] = *(const u32x4*)(xb + (size_t)(row0 + ai * 128 + m * 16) * DM + col + bj * 128);
#pragma unroll
            for (int m = 0; m < 4; ++m) {
                const int row = row0 + ai * 128 + m * 16; float ss = 0.f;
#pragma unroll
                for (int bj = 0; bj < 2; ++bj) {
                    const u32x4 w = pre[m][bj];
                    const f32x4 x0 = {bflo(w[0]), bfhi(w[0]), bflo(w[1]), bfhi(w[1])}, x1 = {bflo(w[2]), bfhi(w[2]), bflo(w[3]), bfhi(w[3])};
                    const f32x4 o0 = x0 + alpha * acc[ai][bj][m][0], o1 = x1 + alpha * acc[ai][bj][m][1];
                    ss += (o0[0] * o0[0] + o0[1] * o0[1]) + (o0[2] * o0[2] + o0[3] * o0[3]) + (o1[0] * o1[0] + o1[1] * o1[1]) + (o1[2] * o1[2] + o1[3] * o1[3]);
                    if (xf) { float* xp = xf + (size_t)row * DM + col + bj * 128; *(f32x4*)xp = o0; *(f32x4*)(xp + 4) = o1; }
                    else *(u32x4*)(xb + (size_t)row * DM + col + bj * 128) = pack8(o0, o1);
                }
                ss += __shfl_xor(ss, 16); ss += __shfl_xor(ss, 32);
                if (fq == 0) part[(size_t)row * 16 + u.pn * 4 + wc] = ss;
            }
        }
    }
};
struct EpiProj {
    static constexpr bool PERM = true, AFTER_DRAIN = false;
    bf16_t* proj; const float* part; const float* rope; int attn;
    DI void operator()(const f32x4 (&acc)[2][2][4][2], const pg8::Unit& u, int wr, int wc, int fr, int fq) const {
        const int row0 = u.pm * 256 + wr * 64 + fr;
        const float sc = (attn || u.pn == 3) ? C2 : 1.0f;
        const bool dorope = attn && u.pn < 3 && (wc & 1) == 0;
#pragma unroll
        for (int ai = 0; ai < 2; ++ai)
#pragma unroll
            for (int m = 0; m < 4; ++m) {
                const int row = row0 + ai * 128 + m * 16; const float rs = row_rstd(part, row, fq) * sc;
#pragma unroll
                for (int bj = 0; bj < 2; ++bj) {
                    f32x4 v0 = acc[ai][bj][m][0] * rs, v1 = acc[ai][bj][m][1] * rs;
                    if (dorope) rope8(v0, v1, rope, row, fq);
                    *(u32x4*)(proj + (size_t)row * DM + u.pn * 256 + bj * 128 + wc * 32 + 8 * fq) = pack8(v0, v1);
                }
            }
    }
};
struct EpiGlu {
    static constexpr bool PERM = true, AFTER_DRAIN = false;
    const bf16_t* y; bf16_t* outp;
    DI void operator()(const f32x4 (&acc)[2][2][4][2], const pg8::Unit& u, int wr, int wc, int fr, int fq) const {
        const int row0 = u.pm * 256 + wr * 64 + fr;
#pragma unroll
        for (int ai = 0; ai < 2; ++ai)
#pragma unroll
            for (int m = 0; m < 4; ++m) {
                const int row = row0 + ai * 128 + m * 16;
#pragma unroll
                for (int bj = 0; bj < 2; ++bj) {
                    const int col = u.pn * 256 + bj * 128 + wc * 32 + 8 * fq;
                    const u32x4 yv = *(const u32x4*)(y + (size_t)row * 768 + col);
                    f32x4 o0, o1;
#pragma unroll
                    for (int e = 0; e < 2; ++e) {
                        o0[2 * e] = bflo(yv[e]) * rcpf(1.0f + ex2(-acc[ai][bj][m][0][2 * e] * LOG2E));
                        o0[2 * e + 1] = bfhi(yv[e]) * rcpf(1.0f + ex2(-acc[ai][bj][m][0][2 * e + 1] * LOG2E));
                        o1[2 * e] = bflo(yv[2 + e]) * rcpf(1.0f + ex2(-acc[ai][bj][m][1][2 * e] * LOG2E));
                        o1[2 * e + 1] = bfhi(yv[2 + e]) * rcpf(1.0f + ex2(-acc[ai][bj][m][1][2 * e + 1] * LOG2E));
                    }
                    *(u32x4*)(outp + (size_t)row * DM + col) = pack8(o0, o1);
                }
            }
    }
};
struct EpiPlain {
    static constexpr bool PERM = true, AFTER_DRAIN = false;
    bf16_t* O; int ldc;
    DI void operator()(const f32x4 (&acc)[2][2][4][2], const pg8::Unit& u, int wr, int wc, int fr, int fq) const {
        const int row0 = u.pm * 256 + wr * 64 + fr;
#pragma unroll
        for (int ai = 0; ai < 2; ++ai)
#pragma unroll
            for (int m = 0; m < 4; ++m)
#pragma unroll
                for (int bj = 0; bj < 2; ++bj)
                    *(u32x4*)(O + (size_t)(row0 + ai * 128 + m * 16) * ldc + u.pn * 256 + bj * 128 + wc * 32 + 8 * fq) = pack8(acc[ai][bj][m][0], acc[ai][bj][m][1]);
    }
};
struct OffsetOrder {
    pg8::StaticOrder so; bool valid;
    DI void init(int M, int N, int G, int c) { valid = c >= 0; so.init(M, N, G, c < 0 ? 0 : c); }
    DI bool next(int i, pg8::Unit& u) const { return valid && so.next(i, u); }
    DI void a_ready(const pg8::Unit&) const {}
    DI void done(const pg8::Unit&) const {}
};

struct Job { const float* src; const float* gain; bf16_t* dst; int K, N, mode, start; };

DI void transpose_item(const float* W, const float* gain, bf16_t* dst, int K, int N, int mode, LAS float* scr, int item, int lane) {
    const int nblk = N / 32, kb = item / nblk, nb = item - kb * nblk, k0 = 64 * kb, n0 = 32 * nb;
    float wv[32];
    const float* wp = W + (size_t)(k0 + (lane >> 5)) * N + n0 + (lane & 31);
#pragma unroll
    for (int i = 0; i < 32; ++i) wv[i] = __builtin_nontemporal_load(wp + (size_t)(2 * i) * N);
    if (gain) {
#pragma unroll
        for (int i = 0; i < 32; ++i) wv[i] *= gain[k0 + 2 * i + (lane >> 5)];
    }
#pragma unroll
    for (int i = 0; i < 32; ++i) scr[(2 * i + (lane >> 5)) * 33 + (lane & 31)] = wv[i];
    asm volatile("s_waitcnt lgkmcnt(0)" ::: "memory");
    int drow0 = n0;
    if (mode == 1) drow0 = (n0 < DFF) ? (n0 / 128) * 256 + (n0 % 128) : ((n0 - DFF) / 128) * 256 + 128 + ((n0 - DFF) % 128);
    const int c = lane & 7;
#pragma unroll
    for (int j = 0; j < 4; ++j) {
        const int n = (lane >> 3) + 8 * j; const LAS float* s = scr + (8 * c) * 33 + n;
        u32x4 o; o.x = pkbf(s[0 * 33], s[1 * 33]); o.y = pkbf(s[2 * 33], s[3 * 33]); o.z = pkbf(s[4 * 33], s[5 * 33]); o.w = pkbf(s[6 * 33], s[7 * 33]);
        *(u32x4*)(dst + (size_t)(drow0 + n) * K + k0 + 8 * c) = o;
    }
    asm volatile("s_waitcnt lgkmcnt(0)" ::: "memory");
}

DI void convert_item(const Params& P, unsigned char* ws, int it, LAS float* scr, int lane) {
    const float* src; const float* gain = nullptr; unsigned char* dst; int K = 1024, N = 1024, mode = 0, item;
    if (it < 38912) {
        const int l = it / 9728, r = it - l * 9728;
        if (r < 2816) { src = P.in[4] + (size_t)l * 1024 * 5632; gain = P.in[3] + l * 1024; dst = ws + WS_F1IN + l * SZ_F1IN; N = 5632; mode = 1; item = r; }
        else if (r < 4224) { src = P.in[5] + (size_t)l * 2816 * 1024; dst = ws + WS_F1OUT + l * SZ_FOUT; K = 2816; item = r - 2816; }
        else if (r < 4736) { src = P.in[7] + (size_t)l * 1024 * 1024; gain = P.in[6] + l * 1024; dst = ws + WS_MIXIN + l * SZ_SQ; item = r - 4224; }
        else if (r < 5248) { src = P.in[8] + (size_t)l * 1024 * 1024; dst = ws + WS_MIXOUT + l * SZ_SQ; item = r - 4736; }
        else if (r < 8064) { src = P.in[12] + (size_t)l * 1024 * 5632; gain = P.in[11] + l * 1024; dst = ws + WS_F2IN + l * SZ_F2IN; N = 5632; mode = 1; item = r - 5248; }
        else if (r < 9472) { src = P.in[13] + (size_t)l * 2816 * 1024; dst = ws + WS_F2OUT + l * SZ_FOUT; K = 2816; item = r - 8064; }
        else { src = P.in[10] + (size_t)l * 1024 * 512; dst = ws + WS_MEMKVW + (size_t)l * 512 * 1024 * 2; N = 512; item = r - 9472; }
    } else if (it < 39488) {
        const int j = (it - 38912) / 288; item = (it - 38912) - 288 * j;
        src = P.in[22] + (size_t)j * 768 * 768; dst = ws + WS_GLU + j * SZ_GLU; K = 768; N = 768;
    } else { item = it - 39488; src = P.in[24]; gain = P.in[23]; dst = ws + WS_F1IN + 2 * SZ_F1IN + (size_t)5632 * 1024 * 2; N = 1536; }
    transpose_item(src, gain, (bf16_t*)dst, K, N, mode, scr, item, lane);
}

DI void prep_phase(const Params& P, LAS unsigned char* lds, const int tid, const int bid) {
    const int lane = tid & 63, wave = tid >> 6;
    const int gw = bid * NWAVES + wave, NGW = gridDim.x * NWAVES;
    unsigned char* ws = P.ws;
    {
        LAS float* scr = (LAS float*)(lds + wave * 8448);
        const int gwu = __builtin_amdgcn_readfirstlane(gw);
#pragma unroll 1
        for (int p = gwu; p < 11840; p += NGW) {
            int it;
            if (p < 9472) it = p;
            else if (p < 10496) { const int q = p - 9472; it = (q >> 8) * 9728 + 9472 + (q & 255); }
            else it = 38912 + (p - 10496);
            convert_item(P, ws, it, scr, lane);
        }
    }
    {
        const float* x = P.in[0]; bf16_t* xb = (bf16_t*)(ws + WS_XB); float* part = (float*)(ws + WS_PART);
        for (int row = gw; row < T; row += NGW) {
            f32x4 v[4]; float ss = 0.f;
#pragma unroll
            for (int j = 0; j < 4; ++j) { v[j] = *(const f32x4*)(x + (size_t)row * DM + 4 * lane + 256 * j); ss += (v[j][0] * v[j][0] + v[j][1] * v[j][1]) + (v[j][2] * v[j][2] + v[j][3] * v[j][3]); }
            ss = wave_sum(ss);
#pragma unroll
            for (int j = 0; j < 4; ++j) {
                u32x2 w; w.x = pkbf(v[j][0], v[j][1]); w.y = pkbf(v[j][2], v[j][3]);
                *(u32x2*)(xb + (size_t)row * DM + 4 * lane + 256 * j) = w;
            }
            if (lane < 16) part[(size_t)row * 16 + lane] = (lane == 0) ? ss : 0.f;
        }
    }
    {
        const float* mem = P.in[1]; const float* g = P.in[9]; bf16_t* mn = (bf16_t*)(ws + WS_MEMNB);
        for (int row = gw; row < 1024; row += NGW) {
            f32x4 v[4]; float ss = 0.f;
#pragma unroll
            for (int j = 0; j < 4; ++j) { v[j] = *(const f32x4*)(mem + (size_t)row * DM + 4 * lane + 256 * j); ss += (v[j][0] * v[j][0] + v[j][1] * v[j][1]) + (v[j][2] * v[j][2] + v[j][3] * v[j][3]); }
            const float rs = rsqrtf(wave_sum(ss) * (1.0f / 1024.0f) + EPS);
#pragma unroll
            for (int j = 0; j < 4; ++j) {
                const f32x4 gg = *(const f32x4*)(g + 4 * lane + 256 * j); const f32x4 o = v[j] * rs * gg;
                u32x2 w; w.x = pkbf(o[0], o[1]); w.y = pkbf(o[2], o[3]);
                *(u32x2*)(mn + (size_t)row * DM + 4 * lane + 256 * j) = w;
            }
        }
    }
    const int gt = bid * NTHREADS + tid, NGT = gridDim.x * NTHREADS;
    {
        const int* pos = (const int*)P.in[2]; float* rope = (float*)(ws + WS_ROPE);
        for (int i = gt; i < T * 8; i += NGT) {
            const int row = i >> 3, f = i & 7;
            const double invs[8] = {1.0, 0.19392274474868576, 0.03760603093086393, 0.007292664737217109, 0.001414213562373095, 0.0002742481756762073, 5.318295896944988e-05, 1.031338537721246e-05};
            double inv = invs[0];
#pragma unroll
            for (int q = 1; q < 8; ++q) inv = (f == q) ? invs[q] : inv;
            const double ang = (double)pos[row] * inv;
            const double k = __builtin_rint(ang * 0.15915494309189535);
            const float rr = (float)(ang - k * 6.283185307179586);
            rope[(size_t)row * 16 + f] = cosf(rr); rope[(size_t)row * 16 + 8 + f] = sinf(rr);
        }
    }
    {
        float* sa = (float*)(ws + WS_S5A); float* sal = (float*)(ws + WS_S5AL); bf16_t* sb = (bf16_t*)(ws + WS_S5B); bf16_t* sc = (bf16_t*)(ws + WS_S5C);
        for (int i = gt; i < 2 * 48 * 64; i += NGT) {
            const int jg = i >> 6, p = i & 63;
            const float dt = expf(P.in[16][jg]);
            const float lr = P.in[14][i], li = P.in[15][i];
            const float mag = expf(lr * dt);
            const float abr = mag * cosf(li * dt), abi = mag * sinf(li * dt);
            const float den = lr * lr + li * li, nr = abr - 1.0f, ni = abi;
            const float fr = (nr * lr + ni * li) / den, fi = (ni * lr - nr * li) / den;
            sa[jg * 128 + p] = abr; sa[jg * 128 + 64 + p] = abi;
            float pr = abr, pi = abi;
#pragma unroll
            for (int q = 0; q < 6; ++q) { const float tr = pr * pr - pi * pi, ti = 2.0f * pr * pi; pr = tr; pi = ti; }
            sal[jg * 128 + p] = pr; sal[jg * 128 + 64 + p] = pi;
            const float* br = P.in[17] + (size_t)i * 16; const float* bi = P.in[18] + (size_t)i * 16;
#pragma unroll 2
            for (int c = 0; c < 16; c += 2) {
                const float r0 = fr * br[c] - fi * bi[c], r1 = fr * br[c + 1] - fi * bi[c + 1];
                const float i0 = fr * bi[c] + fi * br[c], i1 = fr * bi[c + 1] + fi * br[c + 1];
                *(unsigned*)(sb + ((size_t)jg * 128 + p) * 16 + c) = pkbf(r0, r1);
                *(unsigned*)(sb + ((size_t)jg * 128 + 64 + p) * 16 + c) = pkbf(i0, i1);
            }
            const float* cr = P.in[19] + (size_t)jg * 16 * 64; const float* ci = P.in[20] + (size_t)jg * 16 * 64;
#pragma unroll 2
            for (int co = 0; co < 16; ++co)
                *(unsigned*)(sc + ((size_t)jg * 16 + co) * 128 + 2 * p) = pkbf(cr[co * 64 + p], -ci[co * 64 + p]);
        }
    }
    if (bid == 0 && tid < 2) {
        const int j = tid; float s1 = 0.f, s2 = 0.f;
        for (int d = 0; d < 64; ++d) { s1 += P.in[25][j * 64 + d] * P.in[26][j * 64 + d]; s2 += P.in[27][j * 64 + d] * P.in[28][j * 64 + d]; }
        const float li = 0.8f - 0.6f * expf(-0.3f * (float)(2 + j));
        float* cf = (float*)(ws + WS_CTL);
        cf[16 + 2 * j] = expf(s1) - expf(s2) + li; cf[17 + 2 * j] = 1.0f - li;
    }
    if (bid == 0 && tid < 32) ((unsigned*)(ws + WS_CTL))[64 + tid] = 0u;
}

constexpr int MVT_LD = 260;
DI void mem_attn_task(const bf16_t* proj, const bf16_t* mkv, bf16_t* mixcat, int task, LAS unsigned char* lds, int tid) {
    const int wave = tid >> 6, lane = tid & 63, r = lane & 31, h = lane >> 5;
    const int b = task >> 6, hm = (task >> 4) & 3, qb = task & 15;
    const bf16_t* ksrc = mkv + (size_t)(b * 256) * 2048 + hm * 64;
    const bf16_t* vsrc = ksrc + 256;
    LAS bf16_t* vt = (LAS bf16_t*)lds;
#pragma unroll
    for (int i = 0; i < 4; ++i) {
        const int id = tid + 512 * i, m = id >> 3, c = id & 7;
        const u32x4 w = *(const u32x4*)(vsrc + (size_t)m * 2048 + c * 8);
#pragma unroll
        for (int e = 0; e < 4; ++e) { vt[(8 * c + 2 * e) * MVT_LD + m] = (bf16_t)(w[e] & 0xffffu); vt[(8 * c + 2 * e + 1) * MVT_LD + m] = (bf16_t)(w[e] >> 16); }
    }
    LAS unsigned char* kt = lds + 64 * MVT_LD * 2;
#pragma unroll
    for (int i = 0; i < 4; ++i) {
        const int id = tid + 512 * i, m = id >> 3, c = id & 7;
        *(LAS u32x4*)(kt + m * 144 + c * 16) = *(const u32x4*)(ksrc + (size_t)m * 2048 + c * 8);
    }
    __syncthreads();
    const int row = b * SEQ + qb * 256 + wave * 32 + r;
    bf16x8 qf[4];
#pragma unroll
    for (int s = 0; s < 4; ++s) qf[s] = *(const bf16x8*)(proj + (size_t)row * DM + 768 + hm * 64 + 16 * s + 8 * h);
    f32x16 sacc[8];
#pragma unroll
    for (int kb = 0; kb < 8; ++kb) {
#pragma unroll
        for (int i = 0; i < 16; ++i) sacc[kb][i] = 0.f;
#pragma unroll
        for (int s = 0; s < 4; ++s) {
            const bf16x8 kf = *(const LAS bf16x8*)(kt + (kb * 32 + r) * 144 + (16 * s + 8 * h) * 2);
            sacc[kb] = MFMA32(kf, qf[s], sacc[kb]);
        }
    }
    float mx = -INFINITY;
#pragma unroll
    for (int kb = 0; kb < 8; ++kb)
#pragma unroll
        for (int i = 0; i < 16; ++i) mx = fmaxf(mx, sacc[kb][i]);
    mx = fmaxf(mx, __shfl_xor(mx, 32));
    float l = 0.f;
#pragma unroll
    for (int kb = 0; kb < 8; ++kb)
#pragma unroll
        for (int i = 0; i < 16; ++i) { const float p = ex2(sacc[kb][i] - mx); sacc[kb][i] = p; l += p; }
    l += __shfl_xor(l, 32);
    f32x16 oacc[2];
#pragma unroll
    for (int db = 0; db < 2; ++db)
#pragma unroll
        for (int i = 0; i < 16; ++i) oacc[db][i] = 0.f;
#pragma unroll
    for (int kb = 0; kb < 8; ++kb)
#pragma unroll
        for (int s2 = 0; s2 < 2; ++s2) {
            u32x4 pw;
#pragma unroll
            for (int e = 0; e < 4; ++e) pw[e] = pkbf(sacc[kb][8 * s2 + 2 * e], sacc[kb][8 * s2 + 2 * e + 1]);
            const bf16x8 pb = __builtin_bit_cast(bf16x8, pw);
#pragma unroll
            for (int db = 0; db < 2; ++db) {
                const LAS bf16_t* vp = vt + (32 * db + r) * MVT_LD + 32 * kb + 16 * s2 + 4 * h;
                const s16x4 lo = *(const LAS s16x4*)vp, hi = *(const LAS s16x4*)(vp + 8);
                const bf16x8 va = __builtin_shufflevector(lo, hi, 0, 1, 2, 3, 4, 5, 6, 7);
                oacc[db] = MFMA32(va, pb, oacc[db]);
            }
        }
    const float inv = 1.0f / l;
    bf16_t* op = mixcat + (size_t)row * DM + 768 + hm * 64 + 4 * h;
#pragma unroll
    for (int db = 0; db < 2; ++db)
#pragma unroll
        for (int i4 = 0; i4 < 4; ++i4) {
            u32x2 w; w.x = pkbf(oacc[db][4 * i4] * inv, oacc[db][4 * i4 + 1] * inv); w.y = pkbf(oacc[db][4 * i4 + 2] * inv, oacc[db][4 * i4 + 3] * inv);
            *(u32x2*)(op + 32 * db + 8 * i4) = w;
        }
    __syncthreads();
}

constexpr int KT_LD = 272, VT_LD = 144, KT_BYTES = 64 * KT_LD, VT_BYTES = 128 * VT_LD;
DI void diff_attn_task(const bf16_t* proj, const bf16_t* kbuf, const bf16_t* vtb, bf16_t* mixcat, const float* subln, float lam, float oml, int task, LAS unsigned char* lds, int tid) {
    const int wave = tid >> 6, lane = tid & 63, r = lane & 31, h = lane >> 5, sub = wave >> 2, wq = wave & 3;
    const int qb = 31 - task / 24, rem = task % 24, b = rem / 6, hd = rem % 6;
    const int myq0 = qb * 128 + wq * 32, q = myq0 + r, row = b * SEQ + q;
    bf16x8 qf[4];
#pragma unroll
    for (int s = 0; s < 4; ++s) qf[s] = *(const bf16x8*)(proj + (size_t)row * DM + hd * 128 + sub * 64 + 16 * s + 8 * h);
    const int ntiles = 2 * (qb + 1);
    const int kr0 = tid >> 4, kc = tid & 15;
    const int vr0 = tid >> 3, vc = tid & 7;
    const bf16_t* kg = kbuf + (size_t)(b * SEQ + kr0) * 768 + hd * 128 + kc * 8;
    const bf16_t* vg = vtb + ((size_t)(b * 6 + hd) * 128 + vr0) * 4096 + vc * 8;
    u32x4 kreg[2], vreg[2];
#define DA_LOAD(j) do { _Pragma("unroll") for (int i_ = 0; i_ < 2; ++i_) { kreg[i_] = *(const u32x4*)(kg + (size_t)((j) * 64 + 32 * i_) * 768); vreg[i_] = *(const u32x4*)(vg + (size_t)(64 * i_) * 4096 + (j) * 64); } } while (0)
#define DA_WRITE(buf) do { _Pragma("unroll") for (int i_ = 0; i_ < 2; ++i_) { *(LAS u32x4*)(lds + (buf) * KT_BYTES + (kr0 + 32 * i_) * KT_LD + kc * 16) = kreg[i_]; \
        LAS unsigned char* vp_ = lds + 2 * KT_BYTES + (buf) * VT_BYTES + (vr0 + 64 * i_) * VT_LD + vc * 16; \
        u32x2 a_; a_.x = vreg[i_].x; a_.y = vreg[i_].y; u32x2 b_; b_.x = vreg[i_].z; b_.y = vreg[i_].w; *(LAS u32x2*)vp_ = a_; *(LAS u32x2*)(vp_ + 8) = b_; } } while (0)
#define DA_LOADK(j) do { _Pragma("unroll") for (int i_ = 0; i_ < 2; ++i_) kreg[i_] = *(const u32x4*)(kg + (size_t)((j) * 64 + 32 * i_) * 768); } while (0)
#define DA_LOADV(j) do { _Pragma("unroll") for (int i_ = 0; i_ < 2; ++i_) vreg[i_] = *(const u32x4*)(vg + (size_t)(64 * i_) * 4096 + (j) * 64); } while (0)
#define DA_WRITEK(slot) do { _Pragma("unroll") for (int i_ = 0; i_ < 2; ++i_) *(LAS u32x4*)(lds + (slot) * KT_BYTES + (kr0 + 32 * i_) * KT_LD + kc * 16) = kreg[i_]; } while (0)
#define DA_WRITEV(slot) do { _Pragma("unroll") for (int i_ = 0; i_ < 2; ++i_) { LAS unsigned char* vp_ = lds + 3 * KT_BYTES + (slot) * VT_BYTES + (vr0 + 64 * i_) * VT_LD + (vc >> 1) * 32 + (vc & 1) * 8; \
        u32x2 a_; a_.x = vreg[i_].x; a_.y = vreg[i_].y; u32x2 b_; b_.x = vreg[i_].z; b_.y = vreg[i_].w; *(LAS u32x2*)vp_ = a_; *(LAS u32x2*)(vp_ + 16) = b_; } } while (0)
#define DA_QK(S_, slot) do { const LAS unsigned char* kt_ = lds + (slot) * KT_BYTES; __builtin_amdgcn_s_setprio(1); _Pragma("unroll") for (int kb = 0; kb < 2; ++kb) { _Pragma("unroll") for (int i = 0; i < 16; ++i) S_[kb][i] = 0.f; \
        _Pragma("unroll") for (int s_ = 0; s_ < 4; ++s_) { const bf16x8 kf = *(const LAS bf16x8*)(kt_ + (32 * kb + r) * KT_LD + (sub * 64 + 16 * s_ + 8 * h) * 2); S_[kb] = MFMA32(kf, qf[s_], S_[kb]); } } __builtin_amdgcn_s_setprio(0); } while (0)
    DA_LOADK(0); DA_LOADV(0); DA_WRITEK(0); DA_WRITEV(0);
    DA_LOADK(1); DA_WRITEK(1);
    __syncthreads();
    f32x16 oacc[4];
#pragma unroll
    for (int db = 0; db < 4; ++db)
#pragma unroll
        for (int i = 0; i < 16; ++i) oacc[db][i] = 0.f;
    float mrun = -INFINITY, lrun = 0.f;
    f32x16 sA[2], sB[2];
    DA_QK(sA, 0);
    int ks1 = 1, ks2 = 2;
#define DA_STEP(SC, SN, j_) do { const int j = (j_); const int k0 = j * 64; \
        { const int jk = (j + 2 < ntiles) ? j + 2 : ntiles - 1, jv = (j + 1 < ntiles) ? j + 1 : ntiles - 1; DA_LOADK(jk); DA_LOADV(jv); } \
        const bool act = (k0 <= myq0 + 31), actn = (j + 1 < ntiles) && (k0 + 64 <= myq0 + 31); \
        if (actn) DA_QK(SN, ks1); \
        if (act) { \
            const LAS unsigned char* vt = lds + 3 * KT_BYTES + (j & 1) * VT_BYTES; \
            if (k0 + 63 > myq0) { \
                _Pragma("unroll") for (int kb = 0; kb < 2; ++kb) { _Pragma("unroll") for (int i = 0; i < 16; ++i) if (k0 + 32 * kb + crow(i, h) > q) SC[kb][i] = -INFINITY; } } \
            float mx = -INFINITY; \
            _Pragma("unroll") for (int kb = 0; kb < 2; ++kb) { _Pragma("unroll") for (int i = 0; i < 16; ++i) mx = fmaxf(mx, SC[kb][i]); } \
            mx = xor32_max(mx); \
            const float mnew = fmaxf(mrun, mx), alpha = ex2(mrun - mnew); \
            mrun = mnew; \
            SC[0] = SC[0] - mnew; SC[1] = SC[1] - mnew;                                     \
            _Pragma("unroll") for (int kb = 0; kb < 2; ++kb) { _Pragma("unroll") for (int i = 0; i < 16; ++i) SC[kb][i] = ex2(SC[kb][i]); } \
            { const f32x16 t16 = SC[0] + SC[1]; \
              const f32x4 t4 = (f32x4){t16[0], t16[1], t16[2], t16[3]} + (f32x4){t16[4], t16[5], t16[6], t16[7]} + (f32x4){t16[8], t16[9], t16[10], t16[11]} + (f32x4){t16[12], t16[13], t16[14], t16[15]}; \
              lrun = lrun * alpha + ((t4[0] + t4[1]) + (t4[2] + t4[3])); } \
            if (__any(alpha != 1.0f)) { _Pragma("unroll") for (int db = 0; db < 4; ++db) oacc[db] = oacc[db] * alpha; } \
            __builtin_amdgcn_s_setprio(1);                        \
            _Pragma("unroll") for (int kb = 0; kb < 2; ++kb) { _Pragma("unroll") for (int s2 = 0; s2 < 2; ++s2) { \
                u32x4 pw; \
                _Pragma("unroll") for (int e = 0; e < 4; ++e) pw[e] = pkbf(SC[kb][8 * s2 + 2 * e], SC[kb][8 * s2 + 2 * e + 1]); \
                const bf16x8 pb = __builtin_bit_cast(bf16x8, pw); \
                _Pragma("unroll") for (int db = 0; db < 4; ++db) { \
                    const bf16x8 va = *(const LAS bf16x8*)(vt + (32 * db + r) * VT_LD + (2 * kb + s2) * 32 + 16 * h); \
                    oacc[db] = MFMA32(va, pb, oacc[db]); } } } \
            __builtin_amdgcn_s_setprio(0); \
        } \
        DA_WRITEK(ks2); \
        DA_WRITEV((j + 1) & 1); \
        __syncthreads(); \
        ks1 = ks2; ks2 = (ks2 == 2) ? 0 : ks2 + 1; } while (0)
    for (int jj = 0; jj < ntiles; jj += 2) {
        DA_STEP(sA, sB, jj);
        DA_STEP(sB, sA, jj + 1);
    }
#undef DA_STEP
#undef DA_LOADK
#undef DA_LOADV
#undef DA_WRITEK
#undef DA_WRITEV
#undef DA_QK
#undef DA_LOAD
#undef DA_WRITE
    const float ltot = lrun + __shfl_xor(lrun, 32), inv = 1.0f / ltot;
    LAS float* xch = (LAS float*)lds;
    if (sub == 1) {
#pragma unroll
        for (int db = 0; db < 4; ++db)
#pragma unroll
            for (int i = 0; i < 16; ++i) xch[(wq * 64 + db * 16 + i) * 64 + lane] = oacc[db][i] * inv;
    }
    __syncthreads();
    if (sub == 0) {
        float ss = 0.f;
#pragma unroll
        for (int db = 0; db < 4; ++db)
#pragma unroll
            for (int i = 0; i < 16; ++i) { const float d = oacc[db][i] * inv - lam * xch[(wq * 64 + db * 16 + i) * 64 + lane]; oacc[db][i] = d; ss += d * d; }
        ss += __shfl_xor(ss, 32);
        const float rs = rsqrtf(ss * (1.0f / 128.0f) + EPS) * oml;
        bf16_t* op = mixcat + (size_t)row * DM + hd * 128 + 4 * h;
#pragma unroll
        for (int db = 0; db < 4; ++db)
#pragma unroll
            for (int i4 = 0; i4 < 4; ++i4) {
                const f32x4 g = *(const f32x4*)(subln + 32 * db + 8 * i4 + 4 * h);
                u32x2 w; w.x = pkbf(oacc[db][4 * i4] * rs * g[0], oacc[db][4 * i4 + 1] * rs * g[1]); w.y = pkbf(oacc[db][4 * i4 + 2] * rs * g[2], oacc[db][4 * i4 + 3] * rs * g[3]);
                *(u32x2*)(op + 32 * db + 8 * i4) = w;
            }
    }
    __syncthreads();
}

constexpr int HI_LD = 272;
template <int PASS>
DI void s5_task(const bf16_t* proj, const float* sa, const float* sal, const bf16_t* sb, const bf16_t* sc, const float* dvec, float* s5end, bf16_t* ybuf, int j, int task, LAS unsigned char* himg, int lane) {
    const int r = lane & 31, h = lane >> 5, fr = lane & 15, fq = lane >> 4;
    const int rg = task & 15, g = (task >> 4) % 48, b = (task >> 4) / 48;
    const int jg = j * 48 + g;
    float ar[2], ai[2], a2r[2], a2i[2], a3r[2], a3i[2], a4r[2], a4i[2];
#pragma unroll
    for (int pb = 0; pb < 2; ++pb) {
        ar[pb] = sa[jg * 128 + 32 * pb + r]; ai[pb] = sa[jg * 128 + 64 + 32 * pb + r];
        a2r[pb] = ar[pb] * ar[pb] - ai[pb] * ai[pb]; a2i[pb] = 2.0f * ar[pb] * ai[pb];
        a3r[pb] = a2r[pb] * ar[pb] - a2i[pb] * ai[pb]; a3i[pb] = a2r[pb] * ai[pb] + a2i[pb] * ar[pb];
        a4r[pb] = a2r[pb] * a2r[pb] - a2i[pb] * a2i[pb]; a4i[pb] = 2.0f * a2r[pb] * a2i[pb];
    }
    bf16x8 bfrag[4];
#pragma unroll
    for (int nt = 0; nt < 4; ++nt) bfrag[nt] = *(const bf16x8*)(sb + ((size_t)jg * 128 + 32 * nt + r) * 16 + 8 * h);
    bf16x8 cfrag[4]; f32x4 dv = {0.f, 0.f, 0.f, 0.f};
    if (PASS == 2) {
#pragma unroll
        for (int s = 0; s < 4; ++s) cfrag[s] = *(const bf16x8*)(sc + ((size_t)jg * 16 + fr) * 128 + 32 * s + 8 * fq);
        dv = *(const f32x4*)(dvec + j * 768 + g * 16 + 4 * fq);
    }
    float Ir[2] = {0.f, 0.f}, Ii[2] = {0.f, 0.f};
    if (PASS == 2) {
        float lr_[2], li_[2];
#pragma unroll
        for (int pb = 0; pb < 2; ++pb) { lr_[pb] = sal[jg * 128 + 32 * pb + r]; li_[pb] = sal[jg * 128 + 64 + 32 * pb + r]; }
#pragma unroll
        for (int pb = 0; pb < 2; ++pb) {
#pragma unroll
            for (int q2 = 0; q2 < 2; ++q2) { const float tr = lr_[pb] * lr_[pb] - li_[pb] * li_[pb], ti = 2.0f * lr_[pb] * li_[pb]; lr_[pb] = tr; li_[pb] = ti; }
        }
        const float* se = s5end + ((size_t)(b * 16) * 48 + g) * 128;
        for (int c = 0; c < rg; ++c) {
            const int cc = c;
            float sr[2], si[2];
#pragma unroll
            for (int pb = 0; pb < 2; ++pb) { sr[pb] = se[(size_t)cc * 48 * 128 + 32 * pb + r]; si[pb] = se[(size_t)cc * 48 * 128 + 64 + 32 * pb + r]; }
            if (c < rg) {
#pragma unroll
                for (int pb = 0; pb < 2; ++pb) {
                    const float nr = Ir[pb] * lr_[pb] - Ii[pb] * li_[pb] + sr[pb], ni = Ir[pb] * li_[pb] + Ii[pb] * lr_[pb] + si[pb];
                    Ir[pb] = nr; Ii[pb] = ni;
                }
            }
        }
    }
#pragma unroll 1
    for (int ck = 0; ck < 4; ++ck) {
        const int chunk = rg * 4 + ck, t0 = chunk * 64;
        const bf16x8 ufr0 = *(const bf16x8*)(proj + (size_t)(b * SEQ + t0 + r) * DM + g * 16 + 8 * h);
        const bf16x8 ufr1 = *(const bf16x8*)(proj + (size_t)(b * SEQ + t0 + 32 + r) * DM + g * 16 + 8 * h);
#pragma unroll 1
        for (int mt = 0; mt < 2; ++mt) {
            const bf16x8 ufr = mt ? ufr1 : ufr0;
            u32x2 uwp[2];
            if (PASS == 2) {
#pragma unroll
                for (int tb = 0; tb < 2; ++tb) uwp[tb] = *(const u32x2*)(proj + (size_t)(b * SEQ + t0 + 32 * mt + 16 * tb + fr) * DM + g * 16 + 4 * fq);
            }
            f32x16 x[4];
#pragma unroll
            for (int nt = 0; nt < 4; ++nt) {
#pragma unroll
                for (int i = 0; i < 16; ++i) x[nt][i] = 0.f;
                x[nt] = MFMA32(ufr, bfrag[nt], x[nt]);
            }
#pragma unroll
            for (int pb = 0; pb < 2; ++pb) {
                f32x16& re = x[pb]; f32x16& im = x[pb + 2];
                float myIr[4], myIi[4];
#pragma unroll
                for (int qq = 0; qq < 4; ++qq) {
#pragma unroll
                    for (int k = 1; k < 4; ++k) {
                        const float pr = re[4 * qq + k - 1], pi = im[4 * qq + k - 1];
                        re[4 * qq + k] += pr * ar[pb] - pi * ai[pb];
                        im[4 * qq + k] += pr * ai[pb] + pi * ar[pb];
                    }
                    const float er = re[4 * qq + 3], ei = im[4 * qq + 3];
                    const float per = __shfl_xor(er, 32), pei = __shfl_xor(ei, 32);
                    const float eAr = h ? per : er, eAi = h ? pei : ei, eBr = h ? er : per, eBi = h ? ei : pei;
                    const float IBr = Ir[pb] * a4r[pb] - Ii[pb] * a4i[pb] + eAr, IBi = Ir[pb] * a4i[pb] + Ii[pb] * a4r[pb] + eAi;
                    myIr[qq] = h ? IBr : Ir[pb]; myIi[qq] = h ? IBi : Ii[pb];
                    Ir[pb] = IBr * a4r[pb] - IBi * a4i[pb] + eBr; Ii[pb] = IBr * a4i[pb] + IBi * a4r[pb] + eBi;
                }
                if (PASS == 2) {
                    const float pwr[4] = {ar[pb], a2r[pb], a3r[pb], a4r[pb]}, pwi[4] = {ai[pb], a2i[pb], a3i[pb], a4i[pb]};
#pragma unroll
                    for (int i = 0; i < 16; ++i) {
                        const int qq = i >> 2, k = i & 3;
                        const float hr = re[i] + pwr[k] * myIr[qq] - pwi[k] * myIi[qq], hi_ = im[i] + pwr[k] * myIi[qq] + pwi[k] * myIr[qq];
                        *(LAS unsigned*)(himg + crow(i, h) * HI_LD + 4 * (32 * pb + r)) = pkbf(hr, hi_);
                    }
                }
            }
            if (PASS == 2) {
                asm volatile("s_waitcnt lgkmcnt(0)" ::: "memory");
#pragma unroll
                for (int tb = 0; tb < 2; ++tb) {
                    f32x4 d = {0.f, 0.f, 0.f, 0.f};
#pragma unroll
                    for (int s = 0; s < 4; ++s) {
                        const bf16x8 hb = *(const LAS bf16x8*)(himg + (16 * tb + fr) * HI_LD + (32 * s + 8 * fq) * 2);
                        d = MFMA16(cfrag[s], hb, d);
                    }
                    const size_t rowi = (size_t)(b * SEQ + t0 + 32 * mt + 16 * tb + fr);
                    const u32x2 uw = uwp[tb];
                    float yv[4] = {d[0] + dv[0] * bflo(uw.x), d[1] + dv[1] * bfhi(uw.x), d[2] + dv[2] * bflo(uw.y), d[3] + dv[3] * bfhi(uw.y)};
#pragma unroll
                    for (int e = 0; e < 4; ++e) { const float v = yv[e]; const float z = 1.5957691216057308f * (v + 0.044715f * v * v * v); yv[e] = v * rcpf(1.0f + ex2(-z * LOG2E)); }
                    u32x2 w; w.x = pkbf(yv[0], yv[1]); w.y = pkbf(yv[2], yv[3]);
                    *(u32x2*)(ybuf + rowi * 768 + g * 16 + 4 * fq) = w;
                }
                asm volatile("s_waitcnt lgkmcnt(0)" ::: "memory");
            }
        }
    }
    if (PASS == 1 && h == 0) {
        float* se = s5end + ((size_t)(b * 16 + rg) * 48 + g) * 128;
#pragma unroll
        for (int pb = 0; pb < 2; ++pb) { se[32 * pb + r] = Ir[pb]; se[64 + 32 * pb + r] = Ii[pb]; }
    }
}

#define XB_TMO      128
#define XB_XCNT(j)  (256  + 64 * (j))
#define XB_XSUB(j)  (1280 + 64 * (j))
#define XB_XGEN(j)  (2304 + 64 * (j))
#define XB_TOP      3328
#define XB_TOPGEN   3392
#define XCD_BAR_WORDS 3456
#define XB_SPIN_CAP (1u << 18)

__device__ __forceinline__ unsigned xb_ld(unsigned* p)              { return __hip_atomic_load(p, __ATOMIC_RELAXED, __HIP_MEMORY_SCOPE_AGENT); }
__device__ __forceinline__ unsigned xb_add(unsigned* p, unsigned v) { return __hip_atomic_fetch_add(p, v, __ATOMIC_RELAXED, __HIP_MEMORY_SCOPE_AGENT); }
__device__ __forceinline__ unsigned xb_xcc_id() { return (unsigned)__builtin_amdgcn_s_getreg((3 << 11) | 20) & 0xFu; }
#define XB_SPIN(cond, bar) do { unsigned _sp = 0; while (cond) { __builtin_amdgcn_s_sleep(1); \
    if ((++_sp & 255u) == 0u) { if (xb_ld(&(bar)[XB_TMO])) break; if (_sp > XB_SPIN_CAP) { atomicAdd(&(bar)[XB_TMO], 1u); break; } } } } while (0)

struct XcdBarrier {
    unsigned* bar; unsigned x;
    volatile LAS unsigned* st;
};

__device__ __forceinline__ XcdBarrier xcd_barrier_post(unsigned* bar, volatile LAS unsigned* st) {
    XcdBarrier b; b.bar = bar; b.x = xb_xcc_id(); b.st = st;
    if (threadIdx.x == 0) (void)xb_add(&bar[XB_XCNT(b.x)], 1u);
    return b;
}
__device__ __forceinline__ void xcd_barrier_complete(unsigned* bar, unsigned x, unsigned& nloc, unsigned& nx) {
    const unsigned G = gridDim.x * gridDim.y * gridDim.z;
    unsigned sum, cnt, mine, sp = 0u;
    for (;;) {
        sum = 0u; cnt = 0u; mine = 0u;
#pragma unroll
        for (unsigned j = 0; j < 16; ++j) { const unsigned c = xb_ld(&bar[XB_XCNT(j)]); sum += c; cnt += (c > 0u) ? 1u : 0u; mine = (j == x) ? c : mine; }
        if (sum == G) break;
        __builtin_amdgcn_s_sleep(1);
        if ((++sp & 255u) == 0u) { if (xb_ld(&bar[XB_TMO])) break; if (sp > XB_SPIN_CAP) { atomicAdd(&bar[XB_TMO], 1u); break; } }
    }
    nloc = mine > 0u ? mine : 1u; nx = cnt > 0u ? cnt : 1u;
}

__device__ __forceinline__ void xcd_barrier(const XcdBarrier& b) {
    asm volatile("s_waitcnt vmcnt(0)" ::: "memory");
    __syncthreads();
    if (threadIdx.x == 0) {
        unsigned* bar = b.bar;
        __builtin_amdgcn_s_waitcnt(0);
        unsigned nloc = b.st[0], nx = b.st[1];
        if (nloc == 0u) { xcd_barrier_complete(bar, b.x, nloc, nx); b.st[0] = nloc; b.st[1] = nx; }
        const unsigned old = xb_add(&bar[XB_XSUB(b.x)], 1u);
        const unsigned gen = old / nloc;
        if (old + 1u == (gen + 1u) * nloc) {
            __builtin_amdgcn_fence(__ATOMIC_RELEASE, "agent");
            asm volatile("s_waitcnt vmcnt(0)" ::: "memory");
            const unsigned og = xb_add(&bar[XB_TOP], 1u);
            const unsigned tg = og / nx;
            if (og + 1u == (tg + 1u) * nx) xb_add(&bar[XB_TOPGEN], 1u);
            else XB_SPIN(xb_ld(&bar[XB_TOPGEN]) == tg, bar);
            __builtin_amdgcn_fence(__ATOMIC_ACQUIRE, "agent");
            xb_add(&bar[XB_XGEN(b.x)], 1u);
            asm volatile("s_waitcnt vmcnt(0)" ::: "memory");
        } else {
            XB_SPIN(xb_ld(&bar[XB_XGEN(b.x)]) == gen, bar);
            __builtin_amdgcn_fence(__ATOMIC_ACQUIRE, "agent");
            asm volatile("s_waitcnt vmcnt(0)" ::: "memory");
        }
    }
    __syncthreads();
}

constexpr int N_PHASES = 38;
__host__ __device__ inline bool phase_empty(int ph) { if (ph == 0 || ph == 37) return false; const int l = (ph - 1) / 9, sub = (ph - 1) % 9; return ((sub == 4 || sub == 5) && l >= 2) || (sub == 3 && l < 2); }

#ifndef PROBE_DUP
#define PROBE_DUP 0
#endif
__device__ inline bool probe_dup(int ph) {
    if (PROBE_DUP == 0 || ph == 37) return false;
    if (ph == 0) return (PROBE_DUP & 2) != 0;
    const int sub = (ph - 1) % 9;
    return ((PROBE_DUP & 1) && (sub == 0 || sub == 7)) || ((PROBE_DUP & (4 | 64 | 128)) && sub == 3) || ((PROBE_DUP & 8) && sub == 4) || ((PROBE_DUP & 16) && sub == 2) || ((PROBE_DUP & 32) && sub == 5);
}
__global__ void __launch_bounds__(NTHREADS) mega(Params P) {
    extern __shared__ __attribute__((aligned(16))) unsigned char lds_raw[];
    LAS unsigned char* lds = (LAS unsigned char*)lds_raw;
    const int G = gridDim.x;
    if (P.ph_hi < 0) cg::this_grid().sync();
    const int wave_s = __builtin_amdgcn_readfirstlane((int)threadIdx.x >> 6);
    XcdBarrier bar; bar.bar = (unsigned*)(P.ws + WS_BAR); bar.x = 0; bar.st = nullptr;
    if (P.ph_hi - P.ph_lo > 1) {
        LAS unsigned* misc = (LAS unsigned*)(lds + LDS_MISC);
        if (threadIdx.x < 16) misc[threadIdx.x] = 0u;
        __syncthreads();
        bar = xcd_barrier_post((unsigned*)(P.ws + WS_BAR), (volatile LAS unsigned*)(misc + 8));
    }
    bool dup_done = false;
    for (int ph = P.ph_lo; ph < P.ph_hi; ) {
        if (phase_empty(ph)) { ++ph; continue; }
        int lane_ = (int)__builtin_amdgcn_mbcnt_hi(~0u, __builtin_amdgcn_mbcnt_lo(~0u, 0u)); asm volatile("" : "+v"(lane_));
        const int tid = (wave_s << 6) | lane_;
        int bid = blockIdx.x; asm volatile("" : "+s"(bid));
        const int lane = lane_, wave = wave_s;
    unsigned char* ws = P.ws;
    bf16_t* xb = (bf16_t*)(ws + WS_XB); float* part = (float*)(ws + WS_PART); const float* rope = (const float*)(ws + WS_ROPE);
    bf16_t* act = (bf16_t*)(ws + WS_ACT); bf16_t* proj = (bf16_t*)(ws + WS_PROJ); bf16_t* mixcat = (bf16_t*)(ws + WS_MIXCAT); bf16_t* ybuf = (bf16_t*)(ws + WS_YBUF);
    bf16_t* kbuf = (bf16_t*)(ws + WS_KBUF); bf16_t* vtb = (bf16_t*)(ws + WS_VT); bf16_t* mkv = (bf16_t*)(ws + WS_MKV);

        if (ph == 0) {
#ifndef SKIP_PREP
            prep_phase(P, lds, tid, bid);
#endif
        } else if (ph == 37) {
            const float* g = P.in[30]; float* out = P.out;
            for (int row = bid * NWAVES + wave; row < T; row += G * NWAVES) {
                const float pv = (lane < 16) ? part[(size_t)row * 16 + lane] : 0.f;
                const float rs = rsqrtf(wave_sum(pv) * (1.0f / 1024.0f) + EPS);
#pragma unroll
                for (int jj = 0; jj < 4; ++jj) {
                    float* p = out + (size_t)row * DM + 4 * lane + 256 * jj;
                    const f32x4 v = *(const f32x4*)p; const f32x4 gg = *(const f32x4*)(g + 4 * lane + 256 * jj);
                    *(f32x4*)p = v * rs * gg;
                }
            }
        } else {
            const int l = (ph - 1) / 9, sub = (ph - 1) % 9;
            if (sub == 0 || sub == 7) {
                const bf16_t* W = (const bf16_t*)(sub == 0 ? ws + WS_F1IN + l * SZ_F1IN : ws + WS_F2IN + l * SZ_F2IN);
                const int N = (sub == 0 && l == 2) ? 7168 : 5632;
                pg8::Gemm g{xb, W, T, N, 1024}; pg8::StaticOrder S; S.init(T, N, G, bid);
                EpiSwiglu E{act, part, kbuf, vtb, rope};
#ifndef SKIP_FIN
                pg8::gemm_phase<EpiSwiglu, pg8::StaticOrder, true, true>(lds, g, S, E, tid);
#endif
                if (ph == 1) {
                    pg8::Gemm g2{(const bf16_t*)(ws + WS_MEMNB), (const bf16_t*)(ws + WS_MEMKVW), 1024, 2048, 1024}; pg8::StaticOrder S2; S2.init(1024, 2048, G, bid >= G / 2 ? bid - G / 2 : 1 << 20);
                    EpiPlain E2{mkv, 2048};
#ifndef SKIP_PLAIN
                    pg8::gemm_phase<EpiPlain, pg8::StaticOrder, true, true>(lds, g2, S2, E2, tid);
#endif
                }
                {
                    const int tk = (ph == 1) ? 0 : (ph == 8) ? 1 : (ph == 10) ? 2 : (ph == 17) ? 3 : (ph == 26) ? 4 : (ph == 28) ? 5 : -1;
                    if (tk >= 0 && bid >= G / 2 && !dup_done) {
                        LAS float* scr = (LAS float*)(lds + wave * 8448);
                        const int nw = (G - G / 2) * NWAVES, w0 = (bid - G / 2) * NWAVES + wave;
                        const int dend = (tk + 1) * 4864 < 28416 ? (tk + 1) * 4864 : 28416;
#pragma unroll 1
                        for (int d = tk * 4864 + w0; d < dend; d += nw) { const int lq = d / 9472; convert_item(P, ws, (lq + 1) * 9728 + (d - lq * 9472), scr, lane); }
                    }
                }
            } else if (sub == 1 || sub == 6 || sub == 8) {
                const bf16_t* A = (sub == 6) ? mixcat : act;
                const int K = (sub == 6) ? 1024 : DFF;
                const bf16_t* W = (const bf16_t*)(sub == 1 ? ws + WS_F1OUT + l * SZ_FOUT : sub == 8 ? ws + WS_F2OUT + l * SZ_FOUT : ws + WS_MIXOUT + l * SZ_SQ);
                pg8::Gemm g{A, W, T, 1024, K}; pg8::StaticOrder S; S.init(T, 1024, G, bid);
                EpiResid E{ph == 36 ? P.out : (float*)nullptr, xb, part, sub == 6 ? 1.0f : 0.5f};
#ifndef SKIP_RESID
                pg8::gemm_phase<EpiResid, pg8::StaticOrder, true, true>(lds, g, S, E, tid);
#endif
            } else if (sub == 2) {
                pg8::Gemm g{xb, (const bf16_t*)(ws + WS_MIXIN + l * SZ_SQ), T, 1024, 1024}; pg8::StaticOrder S; S.init(T, 1024, G, bid);
                EpiProj E{proj, part, rope, l >= 2 ? 1 : 0};
#ifndef SKIP_PROJ
                pg8::gemm_phase<EpiProj, pg8::StaticOrder, true, true>(lds, g, S, E, tid);
#endif
                if (l < 2 && !dup_done) {
                    asm volatile("s_waitcnt vmcnt(0)" ::: "memory");
                    __syncthreads();
                    pg8::Unit u0;
                    for (int i = 0; S.next(i, u0); ++i) {
                        if (u0.pn < 3) {
#pragma unroll 1
                            for (int k = 0; k < 2; ++k) {
                                const int g_ = 16 * u0.pn + wave + 8 * k, t_ = ((((u0.pm >> 4) * 48 + g_) << 4) | (u0.pm & 15));
                                s5_task<1>(proj, (const float*)(ws + WS_S5A), (const float*)(ws + WS_S5AL), (const bf16_t*)(ws + WS_S5B), (const bf16_t*)(ws + WS_S5C), P.in[21], (float*)(ws + WS_S5END), ybuf, l, t_, lds + wave * 8704, lane);
                            }
                        }
                    }
                }
            } else if (sub == 3) {
#ifndef SKIP_MEM
#endif
                if (dup_done && (PROBE_DUP & 128)) {} else if (l < 2) {
                } else {
                    const float* cf = (const float*)(ws + WS_CTL); const float lam = cf[16 + 2 * (l - 2)], oml = cf[17 + 2 * (l - 2)];
                    unsigned* ctr = (unsigned*)(ws + WS_CTL) + 64 + ((l - 2) * 2 + (dup_done ? 1 : 0)) * 8;
                    LAS unsigned* tk = (LAS unsigned*)(lds + LDS_MISC + 16);
                    const bool firstA = bid < (G * 3) / 4;
#pragma unroll 1
                    for (int pass_ = 0; pass_ < 2; ++pass_) {
                        const int q_ = ((pass_ == 0) == firstA) ? 0 : 1;
                        unsigned* cq = ctr + q_;
                        for (;;) {
                            if (tid == 0) tk[0] = atomicAdd(cq, 1u);
                            __syncthreads();
                            const unsigned t = tk[0];
                            __syncthreads();
                            if (t >= 384u) break;
                            diff_attn_task(proj, kbuf, vtb, mixcat, P.in[29] + (l - 2) * 128, lam, oml, (int)t + (q_ ? 384 : 0), lds, tid);
                        }
                    }
                    for (;;) {
                        if (tid == 0) tk[0] = atomicAdd(ctr + 2, 1u);
                        __syncthreads();
                        const unsigned t = tk[0];
                        __syncthreads();
                        if (t >= 256u) break;
                        mem_attn_task(proj, mkv + l * 512, mixcat, (int)t, lds, tid);
                    }
                }
            } else if (sub == 4) {
                if (!dup_done) for (int t = bid; t < 256; t += G) mem_attn_task(proj, mkv + l * 512, mixcat, t, lds, tid);
                for (int t = bid * NWAVES + wave; t < 3072; t += G * NWAVES)
#ifndef SKIP_S52
                    s5_task<2>(proj, (const float*)(ws + WS_S5A), (const float*)(ws + WS_S5AL), (const bf16_t*)(ws + WS_S5B), (const bf16_t*)(ws + WS_S5C), P.in[21], (float*)(ws + WS_S5END), ybuf, l, t, lds + wave * 8704, lane);
#endif
                    ;
            } else if (sub == 5) {
                pg8::Gemm g{ybuf, (const bf16_t*)(ws + WS_GLU + l * SZ_GLU), T, 768, 768}; pg8::StaticOrder S; S.init(T, 768, G, bid);
                EpiGlu E{ybuf, mixcat};
#ifndef SKIP_GLU
                pg8::gemm_phase<EpiGlu, pg8::StaticOrder, true, true>(lds, g, S, E, tid);
#endif
            }
        }
        if (ph + 1 < P.ph_hi) xcd_barrier(bar);
        if (probe_dup(ph) && !dup_done) dup_done = true; else { dup_done = false; ++ph; }
    }
}

extern "C" void kernel_launch(void* const* d_in, const int* in_sizes, int n_in, void* d_out, int out_size, void* d_ws, size_t ws_size, hipStream_t stream) {
    static int grid = 0;
    if (grid == 0) {
        if (n_in != 31 || ws_size < WS_END) { fprintf(stderr, "kernel_launch: need 31 inputs and %zu bytes of workspace (got %d, %zu)\n", (size_t)WS_END, n_in, ws_size); grid = -1; return; }
        int dev = 0, cus = 0, per_cu = 0;
        (void)hipGetDevice(&dev); (void)hipDeviceGetAttribute(&cus, hipDeviceAttributeMultiprocessorCount, dev);
        if (hipFuncSetAttribute((const void*)mega, hipFuncAttributeMaxDynamicSharedMemorySize, LDS_BYTES) != hipSuccess) { fprintf(stderr, "kernel_launch: hipFuncSetAttribute failed\n"); grid = -1; return; }
        if (hipOccupancyMaxActiveBlocksPerMultiprocessor(&per_cu, (const void*)mega, NTHREADS, LDS_BYTES) != hipSuccess || per_cu < 1) { fprintf(stderr, "kernel_launch: occupancy query says %d\n", per_cu); per_cu = 1; }
        (void)hipGetLastError();
        grid = cus * 1;
    }
    if (grid < 0) return;
    if (hipMemsetAsync(d_ws, 0, WS_ZERO_BYTES, stream) != hipSuccess) { fprintf(stderr, "kernel_launch: memset of the control words failed\n"); return; }
    Params p{};
    for (int i = 0; i < 31; ++i) p.in[i] = (const float*)d_in[i];
    p.out = (float*)d_out; p.ws = (unsigned char*)d_ws;
#if MK_MULTI
    for (int ph = 0; ph < N_PHASES; ++ph) {
        if (phase_empty(ph)) continue;
        p.ph_lo = ph; p.ph_hi = ph + 1;
        hipLaunchKernelGGL(mega, dim3(grid), dim3(NTHREADS), LDS_BYTES, stream, p);
    }
#else
    p.ph_lo = 0; p.ph_hi = N_PHASES;
    void* args[] = {&p};
    hipError_t e = hipLaunchCooperativeKernel((const void*)mega, dim3(grid), dim3(NTHREADS), args, LDS_BYTES, stream);
    if (e != hipSuccess) fprintf(stderr, "kernel_launch: cooperative launch failed: %s (grid %d)\n", hipGetErrorString(e), grid);
#endif
}
```
